# Optimizing an MI355X kernel written in HIP

```python
import jax, jax.numpy as jnp
from jax import lax
import numpy as np

D_MODEL = 2048
BATCH = 4
SEQ = 4096
DEPTH = 2

GRID_W = 64
CTX_LEN = 256
N_BRANCH = 4
BRANCH_W = D_MODEL // 4
RET_HEADS = 4
RET_DK = BRANCH_W // RET_HEADS
RET_CHUNK = 128
ROPE_PAIRS = RET_DK // 4
ROPE_BASE = 10000.0
FNET_GROUPS = 4
FNET_GW = BRANCH_W // FNET_GROUPS
SC_WIDTH = 3
CF_WIDTH = 31
D_FF = 4 * D_MODEL
IN_COLS = 10 * BRANCH_W + N_BRANCH * D_MODEL
EPS = 1e-6

kernel_name = "hybrid_retention_fnet_conv_dit_block"


def rms_norm(x, g):
    x32 = x.astype(jnp.float32)
    y = x32 * lax.rsqrt(jnp.mean(x32 * x32, axis=-1, keepdims=True) + EPS)
    return (y * g.astype(jnp.float32)).astype(x.dtype)


def layer_norm(x, g, b):
    x32 = x.astype(jnp.float32)
    mu = jnp.mean(x32, axis=-1, keepdims=True)
    var = jnp.mean(jnp.square(x32 - mu), axis=-1, keepdims=True)
    y = (x32 - mu) * lax.rsqrt(var + EPS)
    return (y * g.astype(jnp.float32) + b.astype(jnp.float32)).astype(x.dtype)


def depthwise_conv(u, w):
    return lax.conv_general_dilated(u, w[:, None, :].astype(u.dtype), window_strides=(1,), padding="SAME",
                                    dimension_numbers=("NWC", "WIO", "NWC"), feature_group_count=u.shape[-1])


def fourier_mix(u):
    b, l, _ = u.shape
    ug = u.astype(jnp.float32).reshape(b, l, FNET_GROUPS, FNET_GW)
    y = jnp.real(jnp.fft.fftn(ug, axes=(1, 3), norm="ortho"))
    return y.reshape(b, l, BRANCH_W).astype(u.dtype)


def _heads(t):
    b, l, _ = t.shape
    return t.astype(jnp.float32).reshape(b, l, RET_HEADS, RET_DK)


def rope2d(t, cos, sin):
    half = RET_DK // 2
    t1, t2 = t[..., :half], t[..., half:]
    cs, sn = cos[None, :, None, :], sin[None, :, None, :]
    return jnp.concatenate([t1 * cs - t2 * sn, t1 * sn + t2 * cs], axis=-1)


def retention_chunkwise(q, k, v, log_g, s0, strict):
    b, l, h, d = q.shape
    n = l // RET_CHUNK
    idx = jnp.arange(RET_CHUNK, dtype=jnp.float32)
    diff = idx[:, None] - idx[None, :]
    keep = (diff > 0) if strict else (diff >= 0)
    intra = jnp.where(keep[None], jnp.exp(log_g[:, None, None] * jnp.maximum(diff, 0.0)[None]), 0.0)
    q_dec = jnp.exp(log_g[:, None] * (idx + 1.0)[None])
    k_dec = jnp.exp(log_g[:, None] * (RET_CHUNK - 1.0 - idx)[None])
    chunk_dec = jnp.exp(log_g * RET_CHUNK)

    def to_chunks(t):
        return t.reshape(b, n, RET_CHUNK, h, d).transpose(1, 0, 3, 2, 4)

    def step(s, qkv):
        qc, kc, vc = qkv
        scores = jnp.einsum("bhqd,bhkd->bhqk", qc, kc) * intra
        y = jnp.einsum("bhqk,bhkv->bhqv", scores, vc) + jnp.einsum("bhqd,bhdv->bhqv", qc * q_dec[..., None], s)
        s = chunk_dec[:, None, None] * s + jnp.einsum("bhkd,bhkv->bhdv", kc * k_dec[..., None], vc)
        return s, y

    _, y = lax.scan(step, s0, (to_chunks(q), to_chunks(k), to_chunks(v)))
    return y.transpose(1, 0, 3, 2, 4).reshape(b, l, h, d)


def context_state(k, v, log_g):
    l = k.shape[1]
    w = jnp.exp(log_g[:, None] * (l - 1.0 - jnp.arange(l, dtype=jnp.float32))[None])
    return jnp.einsum("blhd,blhv,hl->bhdv", k, v, w)


def bidir_retention(q, k, v, lg_f, lg_b, s_f, s_b):
    y_f = retention_chunkwise(q, k, v, lg_f, s_f, False)
    y_b = retention_chunkwise(q[:, ::-1], k[:, ::-1], v[:, ::-1], lg_b, s_b, True)[:, ::-1]
    return y_f + y_b


def retention_out(y, gate):
    mu = jnp.mean(y, axis=-1, keepdims=True)
    var = jnp.mean(jnp.square(y - mu), axis=-1, keepdims=True)
    yn = ((y - mu) * lax.rsqrt(var + EPS)).reshape(y.shape[0], y.shape[1], BRANCH_W)
    return yn.astype(gate.dtype) * jax.nn.silu(gate)


def merge_branches(parts, y_ret, sc_conv, cf_conv, cf_ln, w_branch, w_out):
    u_f, sc_b, sc_c, sc_x, cf_a, cf_b, gates = parts[4:]
    y_f = fourier_mix(u_f)
    y_sc = sc_b * depthwise_conv(sc_c * sc_x, sc_conv)
    y_cf = jax.nn.silu(layer_norm(depthwise_conv(cf_a * jax.nn.sigmoid(cf_b), cf_conv), cf_ln[0], cf_ln[1]))
    ybr = jnp.stack([y_ret, y_f, y_sc, y_cf], axis=2)
    proj = jnp.einsum("blnw,nwd->blnd", ybr, w_branch)
    b, l, _ = gates.shape
    g = jax.nn.sigmoid(gates.reshape(b, l, N_BRANCH, D_MODEL))
    return jnp.sum(g * proj, axis=2) @ w_out


def sq_relu_mlp(h, w1, w2):
    return jnp.square(jax.nn.relu(h @ w1)) @ w2


def hybrid_layer(x, xc, mod, mod_c, w_in, norm_g, ret_decay, sc_conv, cf_conv, cf_ln, w_branch, w_out,
                 w_ff1, w_ff2, cos, sin, with_ctx):
    sh1, sc1, gt1, sh2, sc2, gt2 = jnp.split(mod[:, None, :], 6, axis=-1)
    csh1, csc1, cgt1, csh2, csc2, cgt2 = jnp.split(mod_c, 6, axis=-1)
    splits = [BRANCH_W * i for i in range(1, 11)]

    h = rms_norm(x, norm_g[0]) * (1.0 + sc1) + sh1
    hc = rms_norm(xc, norm_g[0]) * (1.0 + csc1) + csh1
    parts = jnp.split(h @ w_in, splits, axis=-1)
    if with_ctx:
        parts_c = jnp.split(hc @ w_in, splits, axis=-1)
    else:
        parts_c = jnp.split(hc @ w_in[:, :2 * BRANCH_W], [BRANCH_W], axis=-1)

    lg_f, lg_b = jax.nn.log_sigmoid(ret_decay.astype(jnp.float32))
    k_scale = RET_DK ** -0.5
    k_c = _heads(parts_c[0]) * k_scale
    v_c = _heads(parts_c[1])
    s_f = context_state(k_c, v_c, lg_f)
    s_b = context_state(k_c[:, ::-1], v_c[:, ::-1], lg_b)

    q = rope2d(_heads(parts[2]), cos, sin)
    k = rope2d(_heads(parts[0]), cos, sin) * k_scale
    v = _heads(parts[1])
    y_ret = retention_out(bidir_retention(q, k, v, lg_f, lg_b, s_f, s_b), parts[3])
    mix = merge_branches(parts, y_ret, sc_conv, cf_conv, cf_ln, w_branch, w_out)
    x = x + gt1 * rms_norm(mix, norm_g[1])
    h2 = rms_norm(x, norm_g[2]) * (1.0 + sc2) + sh2
    x = x + gt2 * rms_norm(sq_relu_mlp(h2, w_ff1, w_ff2), norm_g[3])

    if with_ctx:
        zeros = jnp.zeros_like(s_f)
        y_ret_c = retention_out(bidir_retention(_heads(parts_c[2]), k_c, v_c, lg_f, lg_b, zeros, zeros), parts_c[3])
        mix_c = merge_branches(parts_c, y_ret_c, sc_conv, cf_conv, cf_ln, w_branch, w_out)
        xc = xc + cgt1 * rms_norm(mix_c, norm_g[1])
        hc2 = rms_norm(xc, norm_g[2]) * (1.0 + csc2) + csh2
        xc = xc + cgt2 * rms_norm(sq_relu_mlp(hc2, w_ff1, w_ff2), norm_g[3])
    return x, xc


def setup_inputs(seed: int = 0) -> dict:
    key = jax.random.key(seed)
    ks = jax.random.split(key, 18)
    f32 = jnp.float32

    def nrm(k, shape, scale):
        return jax.random.normal(k, shape, f32) * scale

    x = nrm(ks[0], (BATCH, SEQ, D_MODEL), 1.0)
    c = nrm(ks[1], (BATCH, D_MODEL), 1.0)
    ctx = nrm(ks[2], (BATCH, CTX_LEN, D_MODEL), 1.0)
    c_ctx = nrm(ks[3], (D_MODEL,), 1.0)
    w_ada = nrm(ks[4], (DEPTH, D_MODEL, 6 * D_MODEL), 0.5 * D_MODEL ** -0.5)
    b_ada = nrm(ks[5], (DEPTH, 6 * D_MODEL), 0.02)
    norm_g = 1.0 + nrm(ks[6], (DEPTH, 4, D_MODEL), 0.02)
    w_in = nrm(ks[7], (DEPTH, D_MODEL, IN_COLS), D_MODEL ** -0.5)
    base = jnp.log(2.0 ** (5.0 + jnp.arange(RET_HEADS, dtype=f32)) - 1.0)
    ret_decay = base[None, None, :] + nrm(ks[8], (DEPTH, 2, RET_HEADS), 0.1)
    sc_conv = nrm(ks[9], (DEPTH, SC_WIDTH, BRANCH_W), SC_WIDTH ** -0.5)
    cf_conv = nrm(ks[10], (DEPTH, CF_WIDTH, BRANCH_W), CF_WIDTH ** -0.5)
    cf_ln = jnp.stack([1.0 + nrm(ks[11], (DEPTH, BRANCH_W), 0.02), nrm(ks[12], (DEPTH, BRANCH_W), 0.02)], axis=1)
    w_branch = nrm(ks[13], (DEPTH, N_BRANCH, BRANCH_W, D_MODEL), BRANCH_W ** -0.5)
    w_out = nrm(ks[14], (DEPTH, D_MODEL, D_MODEL), D_MODEL ** -0.5)
    w_ff1 = nrm(ks[15], (DEPTH, D_MODEL, D_FF), D_MODEL ** -0.5)
    w_ff2 = nrm(ks[16], (DEPTH, D_FF, D_MODEL), D_FF ** -0.5)
    return {"x": x, "c": c, "ctx": ctx, "c_ctx": c_ctx, "w_ada": w_ada, "b_ada": b_ada, "norm_g": norm_g,
            "w_in": w_in, "ret_decay": ret_decay, "sc_conv": sc_conv, "cf_conv": cf_conv, "cf_ln": cf_ln,
            "w_branch": w_branch, "w_out": w_out, "w_ff1": w_ff1, "w_ff2": w_ff2}


def reference(x, c, ctx, c_ctx, w_ada, b_ada, norm_g, w_in, ret_decay, sc_conv, cf_conv, cf_ln,
              w_branch, w_out, w_ff1, w_ff2):
    n_tok = x.shape[1]
    rows = n_tok // GRID_W
    row = jnp.repeat(jnp.arange(rows, dtype=jnp.float32), GRID_W)
    col = jnp.tile(jnp.arange(GRID_W, dtype=jnp.float32), rows)
    freqs = ROPE_BASE ** (-jnp.arange(ROPE_PAIRS, dtype=jnp.float32) / ROPE_PAIRS)
    ang = jnp.concatenate([row[:, None] * freqs[None], col[:, None] * freqs[None]], axis=-1)
    cos, sin = jnp.cos(ang), jnp.sin(ang)
    xc = ctx
    for layer in range(DEPTH):
        mod = jax.nn.silu(c) @ w_ada[layer] + b_ada[layer]
        mod_c = jax.nn.silu(c_ctx) @ w_ada[layer] + b_ada[layer]
        x, xc = hybrid_layer(x, xc, mod, mod_c, w_in[layer], norm_g[layer], ret_decay[layer], sc_conv[layer],
                             cf_conv[layer], cf_ln[layer], w_branch[layer], w_out[layer], w_ff1[layer],
                             w_ff2[layer], cos, sin, layer < DEPTH - 1)
    return x
```

```cpp
#include <hip/hip_runtime.h>
#include <hip/hip_cooperative_groups.h>
#include <cstdio>
namespace cg = cooperative_groups;
#ifndef NULL_PHASES
#define NULL_PHASES 0
#endif
#ifndef REP_T1
#define REP_T1 -1
#endif
#ifndef REP_T2
#define REP_T2 -1
#endif

#define LAS __attribute__((address_space(3)))
typedef unsigned short bf16_t;
typedef short bf16x8 __attribute__((ext_vector_type(8)));
typedef float f32x4 __attribute__((ext_vector_type(4)));
typedef unsigned u32x4 __attribute__((ext_vector_type(4)));
typedef unsigned u32x2 __attribute__((ext_vector_type(2)));

constexpr int D = 2048, NB = 4, SEQ = 4096, NLAT = NB * SEQ, CTXL = 256, NCTX = NB * CTXL, NROW = NLAT + NCTX;
constexpr int INC = 13312, DFF = 8192;
constexpr int C_K = 0, C_V = 512, C_Q = 1024, C_G = 1536, C_F = 2048, C_SB = 2560, C_SC = 3072, C_SX = 3584, C_CA = 4096, C_CB = 4608, C_GATE = 5120;
constexpr float EPS = 1e-6f;
constexpr int LDS_BYTES = 147456;
constexpr int NTHR = 512;

constexpr size_t SZ_WIN = (size_t)INC * D * 2, SZ_WFF = (size_t)DFF * D * 2, SZ_WOUT = (size_t)D * D * 2, SZ_WBR = (size_t)4 * D * 512 * 2;
constexpr size_t OFF_WIN = 0, OFF_WFF1 = OFF_WIN + SZ_WIN, OFF_WFF2 = OFF_WFF1 + SZ_WFF, OFF_WOUT = OFF_WFF2 + SZ_WFF, OFF_WBR = OFF_WOUT + SZ_WOUT;
constexpr size_t OFF_P = OFF_WBR + SZ_WBR;
constexpr size_t SZ_P = (size_t)NROW * INC * 2;
constexpr size_t OFF_A = OFF_P + SZ_P;
constexpr size_t SZ_A = (size_t)NROW * D * 2;
constexpr size_t OFF_F = OFF_A + SZ_A;
constexpr size_t SZ_F = (size_t)NROW * D * 4;
constexpr size_t OFF_S = OFF_F;
constexpr size_t OFF_PQ = OFF_S + (size_t)2 * 16 * 32 * 16384 * 2;
constexpr size_t OFF_DFT = OFF_PQ + (size_t)2048 * 8192 * 2;
constexpr size_t OFF_SCTX = OFF_DFT + (size_t)4096 * 8192 * 2;
constexpr size_t OFF_PQC = OFF_SCTX + (size_t)16 * 2 * 2 * 16384 * 2;
constexpr size_t OFF_DFTC = OFF_PQC + (size_t)2048 * 512 * 2;
constexpr size_t OFF_FEND = OFF_DFTC + (size_t)256 * 512 * 2;
static_assert(OFF_FEND <= OFF_F + SZ_F, "alias overflow");
constexpr size_t OFF_XB = OFF_F + (size_t)NLAT * D * 2;
static_assert(OFF_XB + (size_t)NLAT * D * 2 <= OFF_SCTX, "residual stream overlaps the context state area");
constexpr size_t OFF_XC = OFF_F + SZ_F;
constexpr size_t OFF_MOD = OFF_XC + (size_t)NCTX * D * 4;
constexpr size_t OFF_ROPEC = OFF_MOD + (size_t)2 * 5 * 12288 * 4;
constexpr size_t OFF_ROPES = OFF_ROPEC + (size_t)4096 * 64 * 4;
constexpr size_t OFF_PART = OFF_ROPES + (size_t)4096 * 64 * 4;
constexpr size_t OFF_DFTP = OFF_PART + (size_t)8 * NCTX * D * 2;
constexpr size_t OFF_BAR = OFF_PART + (size_t)8 * NCTX * D * 4;
constexpr size_t BAR_BYTES = 3456 * 4;
constexpr size_t OFF_DFTCP = OFF_BAR + BAR_BYTES;
constexpr size_t WS_END = OFF_DFTCP + (size_t)256 * 256 * 2;

struct Params {
    const float *x, *c, *ctx, *cctx, *w_ada, *b_ada, *norm_g, *w_in, *ret_decay, *sc_conv, *cf_conv, *cf_ln, *w_branch, *w_out, *w_ff1, *w_ff2;
    float* out;
    unsigned char* ws;
};

__device__ __forceinline__ float bf2f(bf16_t b) { return __uint_as_float(((unsigned)b) << 16); }
__device__ __forceinline__ unsigned pk2(float lo, float hi) { unsigned r; asm volatile("v_cvt_pk_bf16_f32 %0, %1, %2" : "=v"(r) : "v"(lo), "v"(hi)); return r; }
__device__ __forceinline__ bf16_t f2bf(float f) { return (bf16_t)(pk2(f, 0.f) & 0xffffu); }
__device__ __forceinline__ float blo(unsigned u) { return __uint_as_float(u << 16); }
__device__ __forceinline__ float bhi(unsigned u) { return __uint_as_float(u & 0xffff0000u); }
__device__ __forceinline__ float wave_sum(float v) {
#pragma unroll
    for (int o = 1; o < 64; o <<= 1) v += __shfl_xor(v, o);
    return v;
}
__device__ __forceinline__ float sigmoidf_(float x) { return __builtin_amdgcn_rcpf(1.f + __expf(-x)); }
__device__ __forceinline__ float log_sigmoid_(float x) {
    const float e = __expf(-x);
    return e < 0.06f ? -(e * (1.f + e * (-0.5f + e * (0.33333333f + e * (-0.25f + e * 0.2f))))) : -__logf(1.f + e); }
#define MFMA16(a, b, c) __builtin_amdgcn_mfma_f32_16x16x32_bf16((a), (b), (c), 0, 0, 0)

namespace pg8 {
constexpr int BM = 256, BK = 64, HALF = 128, HTB = HALF * BK * 2, STAGE_BYTES = 8 * HTB, NXCD = 8, WGM = 8;
__device__ __forceinline__ int lds_byte(int r, int c) { const int st = (r >> 4) * 2 + (c >> 5), rr = r & 15, cc = c & 31, ob = rr * 64 + cc * 2; return st * 1024 + (ob ^ (((ob >> 9) & 1) << 5)); }
__device__ __forceinline__ void stage_rc(int b, int& R, int& C) { const int st = b / 1024, sb = b % 1024, swz = sb ^ (((sb >> 9) & 1) << 5); R = (st >> 1) * 16 + swz / 64; C = (st & 1) * 32 + (swz % 64) / 2; }
__device__ __forceinline__ int perm32(int rho) { const int n = rho >> 4, i = rho & 15; return 8 * (i >> 2) + 4 * n + (i & 3); }

struct Unit { int pm, pn, z; };
struct Gemm { const bf16_t* A; const bf16_t* Bt; int lda, ldb, K; size_t zA, zB; };

struct Sched {
    int nM, nN, nZ, nwg, G, c, zsplit;
    __device__ __forceinline__ void init(int M, int N, int Z, int G_, int c_) { nM = M / BM; nN = N / BM; nZ = Z; nwg = nM * nN; G = G_; c = c_; zsplit = 0; }
    __device__ __forceinline__ bool next(int i, Unit& u) const {
        const int ti = i / nZ; u.z = i - ti * nZ;
        const long L = (long)ti * G + c; if (L >= nwg) return false;
        int wgid = (int)L; { const int q = nwg / NXCD, r = nwg % NXCD, xcd = wgid % NXCD, off = wgid / NXCD; wgid = (xcd < r ? xcd * (q + 1) : r * (q + 1) + (xcd - r) * q) + off; }
        const int nig = WGM * nN, gid = wgid / nig, fm = gid * WGM, gsz = (nM - fm) < WGM ? (nM - fm) : WGM;
        u.pm = fm + ((wgid % nig) % gsz); u.pn = (wgid % nig) / gsz;
        if (zsplit) { u.z = u.pn / zsplit; u.pn -= u.z * zsplit; }
        return true;
    }
};

struct EpiBf16 {
    static constexpr bool PERM = true, CHAIN = false;
    bf16_t* O; int ldc; int act; size_t zstride;
    __device__ __forceinline__ void operator()(f32x4 (&acc)[2][2][4][2], const Unit& u, int wr, int wc, int fr, int fq) const {
        const int row0 = u.pm * BM + wr * 64 + fr, col0 = u.pn * BM + wc * 32 + 8 * fq;
        if ((act == 2) && (u.pn * BM >= C_GATE)) {
#pragma unroll
            for (int ai = 0; ai < 2; ++ai)
#pragma unroll
                for (int m = 0; m < 4; ++m) { bf16_t* gp = O + (size_t)(row0 + ai * HALF + m * 16) * ldc + C_GATE + ((col0 - C_GATE) >> 1);
#pragma unroll
                    for (int bj = 0; bj < 2; ++bj) { const f32x4 v0 = acc[ai][bj][m][0], v1 = acc[ai][bj][m][1]; unsigned q[8];
#pragma unroll
                        for (int e = 0; e < 4; ++e) { q[e] = (unsigned)fminf(fmaxf(__builtin_rintf(sigmoidf_(v0[e]) * 255.f), 1.f), 255.f); q[4 + e] = (unsigned)fminf(fmaxf(__builtin_rintf(sigmoidf_(v1[e]) * 255.f), 1.f), 255.f); }
                        u32x2 o; o.x = q[0] | (q[1] << 8) | (q[2] << 16) | (q[3] << 24); o.y = q[4] | (q[5] << 8) | (q[6] << 16) | (q[7] << 24);
                        *(u32x2*)(gp + bj * (HALF / 2)) = o; } }
            return;
        }
#pragma unroll
        for (int ai = 0; ai < 2; ++ai)
#pragma unroll
            for (int m = 0; m < 4; ++m) { bf16_t* rowp = O + (size_t)u.z * zstride + (size_t)(row0 + ai * HALF + m * 16) * ldc + col0;
#pragma unroll
                for (int bj = 0; bj < 2; ++bj) { f32x4 v0 = acc[ai][bj][m][0], v1 = acc[ai][bj][m][1];
                    if (act == 1) {
#pragma unroll
                        for (int e = 0; e < 4; ++e) { float a = fmaxf(v0[e], 0.f), b = fmaxf(v1[e], 0.f); v0[e] = a * a; v1[e] = b * b; } }
                    u32x4 o; o.x = pk2(v0[0], v0[1]); o.y = pk2(v0[2], v0[3]); o.z = pk2(v1[0], v1[1]); o.w = pk2(v1[2], v1[3]);
                    *(u32x4*)(rowp + bj * HALF) = o; } }
    }
};
struct EpiF32 {
    static constexpr bool PERM = false, CHAIN = false;
    float* C; int ldc; size_t zstride;
    __device__ __forceinline__ void operator()(f32x4 (&acc)[2][2][4][2], const Unit& u, int wr, int wc, int fr, int fq) const {
        const int row0 = u.pm * BM + wr * 64 + fr, col0 = u.pn * BM + wc * 32 + 4 * fq;
#pragma unroll
        for (int ai = 0; ai < 2; ++ai)
#pragma unroll
            for (int m = 0; m < 4; ++m) { float* rowp = C + (size_t)u.z * zstride + (size_t)(row0 + ai * HALF + m * 16) * ldc + col0;
#pragma unroll
                for (int bj = 0; bj < 2; ++bj)
#pragma unroll
                    for (int n = 0; n < 2; ++n) *(f32x4*)(rowp + bj * HALF + n * 16) = acc[ai][bj][m][n]; }
    }
};
struct EpiGate {
    static constexpr bool PERM = true, CHAIN = true;
    bf16_t* P;
    __device__ __forceinline__ void ratio8(f32x4& v0, f32x4& v1, const u32x4 ga, const u32x4 gb) const {
        v0[0] *= (1.f + __expf(-blo(gb.x))) * __builtin_amdgcn_rcpf(1.f + __expf(-blo(ga.x))); v0[1] *= (1.f + __expf(-bhi(gb.x))) * __builtin_amdgcn_rcpf(1.f + __expf(-bhi(ga.x)));
        v0[2] *= (1.f + __expf(-blo(gb.y))) * __builtin_amdgcn_rcpf(1.f + __expf(-blo(ga.y))); v0[3] *= (1.f + __expf(-bhi(gb.y))) * __builtin_amdgcn_rcpf(1.f + __expf(-bhi(ga.y)));
        v1[0] *= (1.f + __expf(-blo(gb.z))) * __builtin_amdgcn_rcpf(1.f + __expf(-blo(ga.z))); v1[1] *= (1.f + __expf(-bhi(gb.z))) * __builtin_amdgcn_rcpf(1.f + __expf(-bhi(ga.z)));
        v1[2] *= (1.f + __expf(-blo(gb.w))) * __builtin_amdgcn_rcpf(1.f + __expf(-blo(ga.w))); v1[3] *= (1.f + __expf(-bhi(gb.w))) * __builtin_amdgcn_rcpf(1.f + __expf(-bhi(ga.w))); }
    __device__ __forceinline__ void gate8(f32x4& v0, f32x4& v1, const u32x4 g) const {
        v0[0] *= sigmoidf_(blo(g.x)); v0[1] *= sigmoidf_(bhi(g.x)); v0[2] *= sigmoidf_(blo(g.y)); v0[3] *= sigmoidf_(bhi(g.y));
        v1[0] *= sigmoidf_(blo(g.z)); v1[1] *= sigmoidf_(bhi(g.z)); v1[2] *= sigmoidf_(blo(g.w)); v1[3] *= sigmoidf_(bhi(g.w)); }
    __device__ __forceinline__ void step8(f32x4& v0, f32x4& v1, const u32x2 ga, const u32x2 gb, const bool last, u32x4& o) const {
        float s[8], t[8];
#pragma unroll
        for (int e = 0; e < 4; ++e) { s[e] = (float)((ga.x >> (8 * e)) & 0xffu); s[4 + e] = (float)((ga.y >> (8 * e)) & 0xffu); t[e] = (float)((gb.x >> (8 * e)) & 0xffu); t[4 + e] = (float)((gb.y >> (8 * e)) & 0xffu); }
        float r[8];
#pragma unroll
        for (int e = 0; e < 8; ++e) { s[e] = s[e] * (1.f / 255.f); t[e] = last ? 0.f : 255.f * __builtin_amdgcn_rcpf(t[e]); }
#pragma unroll
        for (int e = 0; e < 4; ++e) { r[e] = v0[e] * s[e]; r[4 + e] = v1[e] * s[4 + e]; }
        o.x = pk2(r[0], r[1]); o.y = pk2(r[2], r[3]); o.z = pk2(r[4], r[5]); o.w = pk2(r[6], r[7]);
#pragma unroll
        for (int e = 0; e < 4; ++e) { v0[e] = r[e] * t[e]; v1[e] = r[4 + e] * t[4 + e]; }
    }
    __device__ __forceinline__ void operator()(f32x4 (&acc)[2][2][4][2], const Unit& u, int wr, int wc, int fr, int fq) const {
        const int row0 = u.pm * BM + wr * 64 + fr, col0 = u.pn * BM + wc * 32 + 8 * fq, z = u.z;
        const bool last = (z == 3); const int dz = last ? 0 : D / 2;
        u32x2 ga[16], gb[16];
#pragma unroll
        for (int ch = 0; ch < 8; ++ch) { const size_t row = (size_t)(row0 + (ch >> 2) * HALF + (ch & 3) * 16);
#pragma unroll
            for (int bj = 0; bj < 2; ++bj) { const bf16_t* gp = P + row * INC + C_GATE + ((z * D + col0 + bj * HALF) >> 1); ga[ch * 2 + bj] = *(const u32x2*)gp; gb[ch * 2 + bj] = *(const u32x2*)(gp + dz); } }
#pragma unroll
        for (int ch = 0; ch < 8; ++ch) { const int ai = ch >> 2, m = ch & 3; const size_t row = (size_t)(row0 + ai * HALF + m * 16);
#pragma unroll
            for (int bj = 0; bj < 2; ++bj) { u32x4 o; step8(acc[ai][bj][m][0], acc[ai][bj][m][1], ga[ch * 2 + bj], gb[ch * 2 + bj], last, o);
                if (last) *(u32x4*)(P + row * INC + col0 + bj * HALF) = o; }
        }
    }
};
struct EpiFnet {
    static constexpr bool PERM = true, CHAIN = false;
    bf16_t* Y; int rowbase, Lseq; float scale;
    __device__ __forceinline__ void operator()(f32x4 (&acc)[2][2][4][2], const Unit& u, int wr, int wc, int fr, int fq) const {
        const int row0 = u.pm * BM + wr * 64 + fr, col0 = u.pn * BM + wc * 32 + 8 * fq;
#pragma unroll
        for (int ai = 0; ai < 2; ++ai)
#pragma unroll
            for (int m = 0; m < 4; ++m) { const int k = row0 + ai * HALF + m * 16;
#pragma unroll
                for (int bj = 0; bj < 2; ++bj) { const int n8 = col0 + bj * HALF; const int bg = n8 >> 7, j = n8 & 127, b = bg >> 2, g = bg & 3;
                    const f32x4 v0 = acc[ai][bj][m][0] * scale, v1 = acc[ai][bj][m][1] * scale;
                    u32x4 o; o.x = pk2(v0[0], v0[1]); o.y = pk2(v0[2], v0[3]); o.z = pk2(v1[0], v1[1]); o.w = pk2(v1[2], v1[3]);
                    *(u32x4*)(Y + (size_t)(rowbase + b * Lseq + k) * D + 512 + g * 128 + j) = o; } }
    }
};

template <class Epi>
__device__ __forceinline__ void gemm_phase(LAS unsigned char* lds, const Gemm g, const Sched& S, const Epi& E, const int tid) {
    const int wid = __builtin_amdgcn_readfirstlane(tid >> 6), lane = tid & 63, wr = wid >> 2, wc = wid & 3, fr = lane & 15, fq = lane >> 4;
    const int K = g.K, nt = K / BK;
    unsigned voffA[2], voffB[2];
#pragma unroll
    for (int i = 0; i < 2; ++i) { int R, C; stage_rc(tid * 16 + i * 8192, R, C); const int Rb = Epi::PERM ? ((R & ~31) + perm32(R & 31)) : R;
        voffA[i] = (unsigned)(R * g.lda + C) * 2u; voffB[i] = (unsigned)(Rb * g.ldb + C) * 2u; }
    const size_t kstep = (size_t)(BK * 2);
    const size_t hstepA = (size_t)HALF * g.lda * 2, hstepB = (size_t)HALF * g.ldb * 2;
    const size_t tstepA = 2 * hstepA, tstepB = 2 * hstepB;
    const unsigned ldsw = (unsigned)wid * 1024u;
    const int aoff = lds_byte(wr * 64 + fr, fq * 8), boff = lds_byte(wc * 32 + fr, fq * 8);
#define PG8_SA(b, h) (((b) * 2 + (h)) * HTB)
#define PG8_SB(b, h) ((4 + (b) * 2 + (h)) * HTB)
#define PG8_STAGE(bufoff, gbase, voff) do { _Pragma("unroll") for (int _i = 0; _i < 2; ++_i) \
        __builtin_amdgcn_global_load_lds((const unsigned*)((const char*)(gbase) + (voff)[_i]), (LAS unsigned*)(lds + (bufoff) + ldsw + _i * 8192), 16, 0, 0); } while (0)
#define PG8_LDA(dst, b, h) do { _Pragma("unroll") for (int m = 0; m < 4; ++m) _Pragma("unroll") for (int k = 0; k < 2; ++k) dst[m][k] = *(const LAS bf16x8*)(lds + PG8_SA(b, h) + aoff + m * 2048 + k * 1024); } while (0)
#define PG8_LDB(dst, b, h) do { _Pragma("unroll") for (int n = 0; n < 2; ++n) _Pragma("unroll") for (int k = 0; k < 2; ++k) dst[n][k] = *(const LAS bf16x8*)(lds + PG8_SB(b, h) + boff + n * 2048 + k * 1024); } while (0)
#define PG8_MMA(ai, bj, At, Bt) do { __builtin_amdgcn_s_setprio(1); _Pragma("unroll") for (int m = 0; m < 4; ++m) _Pragma("unroll") for (int n = 0; n < 2; ++n) _Pragma("unroll") for (int k = 0; k < 2; ++k) \
        acc[ai][bj][m][n] = __builtin_amdgcn_mfma_f32_16x16x32_bf16(Bt[n][k], At[m][k], acc[ai][bj][m][n], 0, 0, 0); __builtin_amdgcn_s_setprio(0); } while (0)
#define PG8_WAIT_V(n) asm volatile("s_waitcnt vmcnt(" #n ")" ::: "memory")
#define PG8_WAIT_L(n) asm volatile("s_waitcnt lgkmcnt(" #n ")" ::: "memory")
#define PG8_BAR __builtin_amdgcn_s_barrier()
#define PG8_SCHED __builtin_amdgcn_sched_barrier(0)
    Unit cur, nxt; int ui = 0;
    if (!S.next(0, cur)) return;
    f32x4 acc[2][2][4][2];
#pragma unroll
    for (int a = 0; a < 2; ++a)
#pragma unroll
        for (int b = 0; b < 2; ++b)
#pragma unroll
            for (int m = 0; m < 4; ++m)
#pragma unroll
                for (int n = 0; n < 2; ++n) acc[a][b][m][n] = (f32x4){0.f, 0.f, 0.f, 0.f};
    bf16x8 At[4][2], B0[2][2], B1[2][2];
    const char* cA = (const char*)g.A + ((size_t)cur.z * g.zA) * 2 + (size_t)cur.pm * tstepA;
    const char* cB = (const char*)g.Bt + ((size_t)cur.z * g.zB) * 2 + (size_t)cur.pn * tstepB;
    PG8_STAGE(PG8_SB(0, 0), cB, voffB); PG8_STAGE(PG8_SA(0, 0), cA, voffA); PG8_STAGE(PG8_SB(0, 1), cB + hstepB, voffB); PG8_STAGE(PG8_SA(0, 1), cA + hstepA, voffA);
    if (wr == 1) PG8_BAR;
    PG8_WAIT_V(4); PG8_BAR;
    PG8_STAGE(PG8_SB(1, 0), cB + kstep, voffB); PG8_STAGE(PG8_SA(1, 0), cA + kstep, voffA); PG8_STAGE(PG8_SB(1, 1), cB + hstepB + kstep, voffB);
    PG8_WAIT_V(6); PG8_BAR;
    for (;;) {
        const bool has_next = S.next(ui + 1, nxt);
        const char* nA = has_next ? (const char*)g.A + ((size_t)nxt.z * g.zA) * 2 + (size_t)nxt.pm * tstepA : cA;
        const char* nB = has_next ? (const char*)g.Bt + ((size_t)nxt.z * g.zB) * 2 + (size_t)nxt.pn * tstepB : cB;
        for (int t = 0; t < nt; t += 2) {
            const bool last = (t == nt - 2);
            const char* a1 = cA + (size_t)(t + 1) * kstep;
            const char* a2 = last ? nA : cA + (size_t)(t + 2) * kstep; const char* b2 = last ? nB : cB + (size_t)(t + 2) * kstep;
            const char* a3 = a2 + kstep; const char* b3 = b2 + kstep;
            PG8_LDB(B0, 0, 0); PG8_SCHED; PG8_LDA(At, 0, 0); PG8_STAGE(PG8_SA(1, 1), a1 + hstepA, voffA);
            PG8_WAIT_L(8); PG8_BAR; PG8_WAIT_L(0); PG8_MMA(0, 0, At, B0); PG8_BAR; PG8_SCHED;
            PG8_LDB(B1, 0, 1); PG8_STAGE(PG8_SB(0, 0), b2, voffB);
            PG8_BAR; PG8_WAIT_L(0); PG8_MMA(0, 1, At, B1); PG8_BAR;
            PG8_LDA(At, 0, 1); PG8_STAGE(PG8_SA(0, 0), a2, voffA);
            PG8_BAR; PG8_WAIT_L(0); PG8_MMA(1, 0, At, B0); PG8_BAR; PG8_SCHED;
            PG8_STAGE(PG8_SB(0, 1), b2 + hstepB, voffB);
            PG8_WAIT_V(6); PG8_BAR; PG8_MMA(1, 1, At, B1); PG8_BAR;
            PG8_LDB(B0, 1, 0); PG8_SCHED; PG8_LDA(At, 1, 0); PG8_STAGE(PG8_SA(0, 1), a2 + hstepA, voffA);
            PG8_WAIT_L(8); PG8_BAR; PG8_WAIT_L(0); PG8_MMA(0, 0, At, B0); PG8_BAR; PG8_SCHED;
            PG8_LDB(B1, 1, 1); PG8_STAGE(PG8_SB(1, 0), b3, voffB);
            PG8_BAR; PG8_WAIT_L(0); PG8_MMA(0, 1, At, B1); PG8_BAR;
            PG8_LDA(At, 1, 1); PG8_STAGE(PG8_SA(1, 0), a3, voffA);
            PG8_BAR; PG8_WAIT_L(0); PG8_MMA(1, 0, At, B0); PG8_BAR; PG8_SCHED;
            PG8_STAGE(PG8_SB(1, 1), b3 + hstepB, voffB);
            PG8_WAIT_V(6); PG8_BAR; PG8_MMA(1, 1, At, B1); PG8_BAR;
        }
        E(acc, cur, wr, wc, fr, fq);
        if (!has_next) break;
        if constexpr (!Epi::CHAIN)
#pragma unroll
        for (int a = 0; a < 2; ++a)
#pragma unroll
            for (int b = 0; b < 2; ++b)
#pragma unroll
                for (int m = 0; m < 4; ++m)
#pragma unroll
                    for (int n = 0; n < 2; ++n) acc[a][b][m][n] = (f32x4){0.f, 0.f, 0.f, 0.f};
        cur = nxt; cA = nA; cB = nB; ++ui;
    }
    PG8_WAIT_V(0);
    if (wr == 0) PG8_BAR;
    PG8_BAR;
#undef PG8_SA
#undef PG8_SB
#undef PG8_STAGE
#undef PG8_LDA
#undef PG8_LDB
#undef PG8_MMA
#undef PG8_WAIT_V
#undef PG8_WAIT_L
#undef PG8_BAR
#undef PG8_SCHED
}
}

__device__ __forceinline__ void transpose_item(const float* W, int K, int N, bf16_t* WT, LAS float* scr, int item, int lane, int ldw) {
    const int nblk = N / 64, kb = item / nblk, nb = item % nblk, k0 = 64 * kb, n0 = 64 * nb;
    f32x4 w[16];
#pragma unroll
    for (int i = 0; i < 16; ++i) { const int kk = 4 * i + (lane >> 4); w[i] = __builtin_nontemporal_load((const f32x4*)(W + (size_t)(k0 + kk) * N + n0 + (lane & 15) * 4)); }
#pragma unroll
    for (int i = 0; i < 16; ++i) { const int kk = 4 * i + (lane >> 4); LAS float* d = scr + kk * 65 + (lane & 15) * 4; d[0] = w[i][0]; d[1] = w[i][1]; d[2] = w[i][2]; d[3] = w[i][3]; }
    asm volatile("s_waitcnt lgkmcnt(0)" ::: "memory");
    const int c = lane & 7;
#pragma unroll
    for (int j = 0; j < 8; ++j) { const int n = (lane >> 3) + 8 * j; const LAS float* s = scr + (8 * c) * 65 + n;
        u32x4 o; o.x = pk2(s[0 * 65], s[1 * 65]); o.y = pk2(s[2 * 65], s[3 * 65]); o.z = pk2(s[4 * 65], s[5 * 65]); o.w = pk2(s[6 * 65], s[7 * 65]);
        *(u32x4*)(WT + (size_t)(n0 + n) * ldw + k0 + 8 * c) = o; }
    asm volatile("s_waitcnt lgkmcnt(0)" ::: "memory");
}
__device__ __forceinline__ void convert_weights(const Params& p, int l, LAS unsigned char* lds, int tid, int mask, int vb, int nvb, int lo256 = 0, int hi256 = 256) {
    const int wave = tid >> 6, lane = tid & 63;
    LAS float* scr = (LAS float*)(lds + wave * 16640);
    const int gw = vb * 8 + wave, NGW = nvb * 8;
    constexpr int I_IN = (D / 64) * (INC / 64), I_F1 = (D / 64) * (DFF / 64), I_F2 = (DFF / 64) * (D / 64), I_O = (D / 64) * (D / 64), I_BR = (512 / 64) * (D / 64);
    constexpr int NIT = I_IN + I_F1 + I_F2 + I_O + 4 * I_BR;
    const int n0 = (mask & 1) ? I_IN : 0, n1 = (mask & 2) ? I_F1 : 0, n2 = (mask & 4) ? I_F2 : 0, n3 = (mask & 8) ? I_O : 0, n4 = (mask & 16) ? 4 * I_BR : 0;
    const int total = n0 + n1 + n2 + n3 + n4;
    const int it_lo = (int)(((long)total * lo256) >> 8), it_hi = (int)(((long)total * hi256) >> 8);
    for (int it = it_lo + gw; it < it_hi; it += NGW) {
        int r = it;
        if (r < n0) { transpose_item(p.w_in + (size_t)l * D * INC, D, INC, (bf16_t*)(p.ws + OFF_WIN), scr, r, lane, D); continue; } r -= n0;
        if (r < n1) { transpose_item(p.w_ff1 + (size_t)l * D * DFF, D, DFF, (bf16_t*)(p.ws + OFF_WFF1), scr, r, lane, D); continue; } r -= n1;
        if (r < n2) { transpose_item(p.w_ff2 + (size_t)l * DFF * D, DFF, D, (bf16_t*)(p.ws + OFF_WFF2), scr, r, lane, DFF); continue; } r -= n2;
        if (r < n3) { transpose_item(p.w_out + (size_t)l * D * D, D, D, (bf16_t*)(p.ws + OFF_WOUT), scr, r, lane, D); continue; } r -= n3;
        const int nb = r / I_BR; r -= nb * I_BR;
        transpose_item(p.w_branch + ((size_t)l * 4 + nb) * 512 * D, 512, D, (bf16_t*)(p.ws + OFF_WBR) + (size_t)nb * 512, scr, r, lane, D);
    }
}
__device__ __forceinline__ void phase_A(const Params& p, LAS unsigned char* lds, int tid) {
    const int blk = blockIdx.x, G = gridDim.x;
    float* mod = (float*)(p.ws + OFF_MOD);
    for (int item = blk; item < 96; item += G) {
        LAS float* ssil = (LAS float*)lds;
        LAS float* red = (LAS float*)(lds + 40960);
        for (int idx = tid; idx < 5 * D; idx += NTHR) { const int r = idx >> 11, k = idx & 2047; const float cv = r < 4 ? p.c[r * D + k] : p.cctx[k]; ssil[idx] = cv / (1.f + __expf(-cv)); }
        __syncthreads();
        const int l = item / 48, n0 = (item % 48) * 256, cgi = tid & 63, ks = tid >> 6;
        float acc[5][4];
#pragma unroll
        for (int r = 0; r < 5; ++r)
#pragma unroll
            for (int j = 0; j < 4; ++j) acc[r][j] = 0.f;
        const float* wp = p.w_ada + ((size_t)(l * D + ks * 256)) * 12288 + n0 + cgi * 4;
#pragma unroll 4
        for (int k = 0; k < 256; ++k) { const f32x4 w = __builtin_nontemporal_load((const f32x4*)(wp + (size_t)k * 12288));
#pragma unroll
            for (int r = 0; r < 5; ++r) { const float s = ssil[r * D + ks * 256 + k];
#pragma unroll
                for (int j = 0; j < 4; ++j) acc[r][j] += s * w[j]; } }
#pragma unroll
        for (int r = 0; r < 5; ++r)
#pragma unroll
            for (int j = 0; j < 4; ++j) red[(ks * 64 + cgi) * 20 + r * 4 + j] = acc[r][j];
        __syncthreads();
        for (int o = tid; o < 1280; o += NTHR) { const int r = o >> 8, cc = o & 255; float s = p.b_ada[l * 12288 + n0 + cc];
#pragma unroll
            for (int k2 = 0; k2 < 8; ++k2) s += red[(k2 * 64 + (cc >> 2)) * 20 + r * 4 + (cc & 3)];
            mod[(size_t)(l * 5 + r) * 12288 + n0 + cc] = s; }
        __syncthreads();
    }
    float* rc = (float*)(p.ws + OFF_ROPEC); float* rs = (float*)(p.ws + OFF_ROPES);
    for (int idx = blk * NTHR + tid; idx < 4096 * 64; idx += G * NTHR) { const int t = idx >> 6, s = idx & 63; const int pos = s < 32 ? (t >> 6) : (t & 63);
        const float fr = __builtin_amdgcn_exp2f(-(float)(s & 31) * (13.287712379549449f / 32.f)); const float rev = (float)pos * fr * 0.15915494309189535f;
        rc[idx] = __builtin_amdgcn_cosf(rev); rs[idx] = __builtin_amdgcn_sinf(rev); }
    if (G > 96) { if (blk >= 96) convert_weights(p, 0, lds, tid, 31, blk - 96, G - 96, 0, 85); convert_weights(p, 0, lds, tid, 31, blk, G, 85, 256); }
    else convert_weights(p, 0, lds, tid, 31, blk, G);
}

__device__ __forceinline__ void rowop(const Params& p, int nrows, const float* xin_lat, const float* xin_ctx, bool has_add, int l_add, int which_gate, int gi_add,
                                      bool has_xout, float* xout_lat, float* xout_ctx, bool has_h, int l_h, int gi_h, int which_sc, int which_sh, int nz_ctx, int tid, const bool xin_b16, const bool xout_b16) {
    const int wave = tid >> 6, lane = tid & 63;
    const float* mod = (const float*)(p.ws + OFF_MOD);
    const bf16_t* add = (const bf16_t*)(p.ws + OFF_F);
    const bf16_t* part = (const bf16_t*)(p.ws + OFF_PART);
    bf16_t* hout = (bf16_t*)(p.ws + OFF_A);
    const int NGW = gridDim.x * 8;
    auto load_row = [&](int row, f32x4 (&x)[8], f32x4 (&a)[8]) {
        if (row < NLAT && xin_b16) { const bf16_t* xb = (const bf16_t*)xin_lat + (size_t)row * D;
#pragma unroll
            for (int j = 0; j < 8; ++j) { const u32x2 r = __builtin_nontemporal_load((const u32x2*)(xb + (j * 64 + lane) * 4)); x[j][0] = blo(r.x); x[j][1] = bhi(r.x); x[j][2] = blo(r.y); x[j][3] = bhi(r.y); }
        } else { const float* xi = row < NLAT ? xin_lat + (size_t)row * D : xin_ctx + (size_t)(row - NLAT) * D;
#pragma unroll
            for (int j = 0; j < 8; ++j) x[j] = __builtin_nontemporal_load((const f32x4*)(xi + (j * 64 + lane) * 4)); }
        if (has_add) {
            if (row >= NLAT && nz_ctx > 0) {
#pragma unroll
                for (int j = 0; j < 8; ++j) a[j] = (f32x4){0.f, 0.f, 0.f, 0.f};
                for (int z = 0; z < nz_ctx; ++z) { const bf16_t* ap = part + ((size_t)z * NCTX + (row - NLAT)) * D;
#pragma unroll
                    for (int j = 0; j < 8; ++j) { const u32x2 r = *(const u32x2*)(ap + (j * 64 + lane) * 4); a[j][0] += blo(r.x); a[j][1] += bhi(r.x); a[j][2] += blo(r.y); a[j][3] += bhi(r.y); } }
            } else { const bf16_t* ap = add + (size_t)row * D;
#pragma unroll
                for (int j = 0; j < 8; ++j) { const u32x2 r = __builtin_nontemporal_load((const u32x2*)(ap + (j * 64 + lane) * 4)); a[j][0] = blo(r.x); a[j][1] = bhi(r.x); a[j][2] = blo(r.y); a[j][3] = bhi(r.y); } }
        }
    };
    auto proc_row = [&](int row, f32x4 (&x)[8], f32x4 (&a)[8]) {
        const int r = row < NLAT ? (row >> 12) : 4;
        if (has_add) {
            float ss = 0.f;
#pragma unroll
            for (int j = 0; j < 8; ++j) ss += a[j][0] * a[j][0] + a[j][1] * a[j][1] + a[j][2] * a[j][2] + a[j][3] * a[j][3];
            ss = wave_sum(ss); const float rs = rsqrtf(ss * (1.f / D) + EPS);
            const float* gn = p.norm_g + (size_t)(l_add * 4 + gi_add) * D; const float* gt = mod + (size_t)(l_add * 5 + r) * 12288 + which_gate * D;
#pragma unroll
            for (int j = 0; j < 8; ++j) { const int col = (j * 64 + lane) * 4; const f32x4 g4 = *(const f32x4*)(gn + col), t4 = *(const f32x4*)(gt + col); x[j] = x[j] + t4 * (a[j] * rs * g4); }
            if (has_xout) {
                if (row < NLAT && xout_b16) { bf16_t* xb = (bf16_t*)xout_lat + (size_t)row * D;
#pragma unroll
                    for (int j = 0; j < 8; ++j) { u32x2 o; o.x = pk2(x[j][0], x[j][1]); o.y = pk2(x[j][2], x[j][3]); __builtin_nontemporal_store(o, (u32x2*)(xb + (j * 64 + lane) * 4)); }
                } else { float* xo = row < NLAT ? xout_lat + (size_t)row * D : xout_ctx + (size_t)(row - NLAT) * D;
#pragma unroll
                    for (int j = 0; j < 8; ++j) __builtin_nontemporal_store(x[j], (f32x4*)(xo + (j * 64 + lane) * 4)); } }
        }
        if (has_h) {
            float ss = 0.f;
#pragma unroll
            for (int j = 0; j < 8; ++j) ss += x[j][0] * x[j][0] + x[j][1] * x[j][1] + x[j][2] * x[j][2] + x[j][3] * x[j][3];
            ss = wave_sum(ss); const float rs = rsqrtf(ss * (1.f / D) + EPS);
            const float* gn = p.norm_g + (size_t)(l_h * 4 + gi_h) * D; const float* sc = mod + (size_t)(l_h * 5 + r) * 12288 + which_sc * D; const float* sh = mod + (size_t)(l_h * 5 + r) * 12288 + which_sh * D;
#pragma unroll
            for (int j = 0; j < 8; ++j) { const int col = (j * 64 + lane) * 4; const f32x4 g4 = *(const f32x4*)(gn + col), s4 = *(const f32x4*)(sc + col), h4 = *(const f32x4*)(sh + col);
                const f32x4 v = (x[j] * rs * g4) * (s4 + 1.f) + h4; u32x2 o; o.x = pk2(v[0], v[1]); o.y = pk2(v[2], v[3]); *(u32x2*)(hout + (size_t)row * D + col) = o; }
        }
    };
    int r0 = blockIdx.x * 8 + wave;
    if (r0 < nrows) {
        f32x4 xA[8], aA[8], xB[8], aB[8];
        load_row(r0, xA, aA);
#pragma unroll 1
        for (;;) {
            const int r1 = r0 + NGW;
            if (r1 < nrows) load_row(r1, xB, aB);
            proc_row(r0, xA, aA);
            if (r1 >= nrows) break;
            r0 = r1 + NGW;
            if (r0 < nrows) load_row(r0, xA, aA);
            proc_row(r1, xB, aB);
            if (r0 >= nrows) break;
        }
    }
}

__device__ __forceinline__ void gen_dft(const Params& p, LAS unsigned char* lds, int tid, int vb, int nvb) {
    LAS bf16_t* lut = (LAS bf16_t*)lds;
    for (int m = tid; m < 4096; m += NTHR) lut[m] = f2bf(__builtin_amdgcn_cosf((float)m * (1.f / 4096.f)));
    __syncthreads();
    bf16_t* T = (bf16_t*)(p.ws + OFF_DFTP);
    for (int v = vb * NTHR + tid; v < 4096 * 512; v += nvb * NTHR) { const int k = v >> 9, n8 = (v & 511) * 8;
        unsigned w[4];
#pragma unroll
        for (int i = 0; i < 4; ++i) { unsigned ab[2];
#pragma unroll
            for (int e = 0; e < 2; ++e) { const int n = n8 + 2 * i + e; unsigned val;
                if (n < 2048) val = lut[(k * n) & 4095]; else if (n == 2048) val = lut[(k * 2048) & 4095]; else val = lut[(k * (n - 2048) + 1024) & 4095];
                ab[e] = val; }
            w[i] = ab[0] | (ab[1] << 16); }
        u32x4 o; o.x = w[0]; o.y = w[1]; o.z = w[2]; o.w = w[3]; *(u32x4*)(T + (size_t)k * 4096 + n8) = o; }
    bf16_t* Tc = (bf16_t*)(p.ws + OFF_DFTCP);
    for (int v = vb * NTHR + tid; v < 256 * 32; v += nvb * NTHR) { const int k = v >> 5, n8 = (v & 31) * 8;
        unsigned w[4];
#pragma unroll
        for (int i = 0; i < 4; ++i) { unsigned ab[2];
#pragma unroll
            for (int e = 0; e < 2; ++e) { const int n = n8 + 2 * i + e; unsigned val;
                if (n < 128) val = lut[(k * n * 16) & 4095]; else if (n == 128) val = lut[(k * 2048) & 4095]; else val = lut[(k * (n - 128) * 16 + 1024) & 4095];
                ab[e] = val; }
            w[i] = ab[0] | (ab[1] << 16); }
        u32x4 o; o.x = w[0]; o.y = w[1]; o.z = w[2]; o.w = w[3]; *(u32x4*)(Tc + (size_t)k * 256 + n8) = o; }
    __syncthreads();
}

__device__ __forceinline__ void ustate_item(const Params& p, int l, int item, LAS unsigned char* lds, int tid) {
    const int wave = tid >> 6, lane = tid & 63, fr = lane & 15, fq = lane >> 4;
    const bf16_t* P = (const bf16_t*)(p.ws + OFF_P);
    const float* ropec = (const float*)(p.ws + OFF_ROPEC); const float* ropes = (const float*)(p.ws + OFF_ROPES);
    bf16_t* Sg = (bf16_t*)(p.ws + OFF_S); bf16_t* Sc = (bf16_t*)(p.ws + OFF_SCTX);
    int h, c, row0; bool rope; bf16_t *Uf, *Ub;
    if (item < 512) { const int bh = item >> 5; c = item & 31; const int b = bh >> 2; h = bh & 3; row0 = b * SEQ + c * 128; rope = true;
        Uf = Sg + ((size_t)bh * 32 + c) * 16384; Ub = Sg + ((size_t)(16 + bh) * 32 + c) * 16384; }
    else { const int it = item - 512, bh = it >> 1; c = it & 1; const int b = bh >> 2; h = bh & 3; row0 = NLAT + b * CTXL + c * 128; rope = false;
        Uf = Sc + ((size_t)(bh * 2 + 0) * 2 + c) * 16384; Ub = Sc + ((size_t)(bh * 2 + 1) * 2 + c) * 16384; }
    const float lgf = log_sigmoid_(p.ret_decay[l * 8 + h]), lgb = log_sigmoid_(p.ret_decay[l * 8 + 4 + h]);
    const float kscale = 0.08838834764831845f;
    LAS bf16_t* kT = (LAS bf16_t*)lds; LAS bf16_t* vF = (LAS bf16_t*)(lds + 34816); LAS bf16_t* vB = (LAS bf16_t*)(lds + 69632);
#pragma unroll
    for (int w = 0; w < 2; ++w) { const int wk = tid + w * NTHR, j = wk & 127, dg = wk >> 7, d0 = dg * 8;
        const bf16_t* kp = P + (size_t)(row0 + j) * INC + C_K + h * 128 + d0;
        const u32x4 r1 = *(const u32x4*)kp, r2 = *(const u32x4*)(kp + 64);
        float k1[8], k2[8];
        k1[0] = blo(r1.x); k1[1] = bhi(r1.x); k1[2] = blo(r1.y); k1[3] = bhi(r1.y); k1[4] = blo(r1.z); k1[5] = bhi(r1.z); k1[6] = blo(r1.w); k1[7] = bhi(r1.w);
        k2[0] = blo(r2.x); k2[1] = bhi(r2.x); k2[2] = blo(r2.y); k2[3] = bhi(r2.y); k2[4] = blo(r2.z); k2[5] = bhi(r2.z); k2[6] = blo(r2.w); k2[7] = bhi(r2.w);
        if (rope) { const int t = c * 128 + j; const float* cp = ropec + t * 64 + d0; const float* sp = ropes + t * 64 + d0;
            const f32x4 c0 = *(const f32x4*)cp, c1 = *(const f32x4*)(cp + 4), s0 = *(const f32x4*)sp, s1 = *(const f32x4*)(sp + 4);
#pragma unroll
            for (int i = 0; i < 8; ++i) { const float cs = i < 4 ? c0[i & 3] : c1[i & 3], sn = i < 4 ? s0[i & 3] : s1[i & 3]; const float a = k1[i], bq = k2[i]; k1[i] = a * cs - bq * sn; k2[i] = a * sn + bq * cs; } }
#pragma unroll
        for (int i = 0; i < 8; ++i) { kT[(d0 + i) * 136 + j] = f2bf(k1[i] * kscale); kT[(d0 + 64 + i) * 136 + j] = f2bf(k2[i] * kscale); }
    }
#pragma unroll
    for (int w = 0; w < 4; ++w) { const int wk = tid + w * NTHR, j = wk & 127, v0 = (wk >> 7) * 8;
        const u32x4 rv = *(const u32x4*)(P + (size_t)(row0 + j) * INC + C_V + h * 128 + v0);
        const float wf = __expf(lgf * (float)(127 - j)), wb = __expf(lgb * (float)j);
        float vv[8]; vv[0] = blo(rv.x); vv[1] = bhi(rv.x); vv[2] = blo(rv.y); vv[3] = bhi(rv.y); vv[4] = blo(rv.z); vv[5] = bhi(rv.z); vv[6] = blo(rv.w); vv[7] = bhi(rv.w);
#pragma unroll
        for (int i = 0; i < 8; ++i) { vF[(v0 + i) * 136 + j] = f2bf(vv[i] * wf); vB[(v0 + i) * 136 + j] = f2bf(vv[i] * wb); } }
    __syncthreads();
#pragma unroll
    for (int dir = 0; dir < 2; ++dir) {
        LAS bf16_t* vX = dir == 0 ? vF : vB; bf16_t* U = dir == 0 ? Uf : Ub;
        f32x4 acc[8];
#pragma unroll
        for (int i = 0; i < 8; ++i) acc[i] = (f32x4){0.f, 0.f, 0.f, 0.f};
#pragma unroll
        for (int ks = 0; ks < 4; ++ks) { const bf16x8 a = *(const LAS bf16x8*)(kT + (wave * 16 + fr) * 136 + ks * 32 + fq * 8);
#pragma unroll
            for (int vt = 0; vt < 8; ++vt) { const bf16x8 bb = *(const LAS bf16x8*)(vX + (vt * 16 + fr) * 136 + ks * 32 + fq * 8); acc[vt] = MFMA16(a, bb, acc[vt]); } }
#pragma unroll
        for (int vt = 0; vt < 8; ++vt) { const int v = vt * 16 + fr, d0 = wave * 16 + fq * 4; u32x2 o; o.x = pk2(acc[vt][0], acc[vt][1]); o.y = pk2(acc[vt][2], acc[vt][3]); *(u32x2*)(U + v * 128 + d0) = o; }
    }
    __syncthreads();
}
__device__ __forceinline__ void scan_phase(const Params& p, int l, int tid) {
    bf16_t* Sg = (bf16_t*)(p.ws + OFF_S); const bf16_t* Sc = (const bf16_t*)(p.ws + OFF_SCTX);
    for (int gidx = blockIdx.x * NTHR + tid; gidx < 16 * 2 * 4096; gidx += gridDim.x * NTHR) {
        const int e4 = gidx & 4095, dir = (gidx >> 12) & 1, bh = gidx >> 13, h = bh & 3;
        const float dec = __expf(log_sigmoid_(p.ret_decay[l * 8 + dir * 4 + h]) * 128.f);
        bf16_t* base = Sg + ((size_t)(dir * 16 + bh) * 32) * 16384 + e4 * 4;
        const bf16_t* uc = Sc + ((size_t)(bh * 2 + dir) * 2) * 16384 + e4 * 4;
        const u32x2 u0 = *(const u32x2*)uc, u1 = *(const u32x2*)(uc + 16384);
        u32x2 uu[32];
#pragma unroll
        for (int c = 0; c < 32; ++c) uu[c] = *(const u32x2*)(base + (size_t)c * 16384);
        float S0, S1, S2, S3;
        if (dir == 0) { S0 = dec * blo(u0.x) + blo(u1.x); S1 = dec * bhi(u0.x) + bhi(u1.x); S2 = dec * blo(u0.y) + blo(u1.y); S3 = dec * bhi(u0.y) + bhi(u1.y);
#pragma unroll
            for (int c = 0; c < 32; ++c) { u32x2 o; o.x = pk2(S0, S1); o.y = pk2(S2, S3); *(u32x2*)(base + (size_t)c * 16384) = o;
                S0 = dec * S0 + blo(uu[c].x); S1 = dec * S1 + bhi(uu[c].x); S2 = dec * S2 + blo(uu[c].y); S3 = dec * S3 + bhi(uu[c].y); } }
        else { S0 = blo(u0.x) + dec * blo(u1.x); S1 = bhi(u0.x) + dec * bhi(u1.x); S2 = blo(u0.y) + dec * blo(u1.y); S3 = bhi(u0.y) + dec * bhi(u1.y);
#pragma unroll
            for (int c = 31; c >= 0; --c) { u32x2 o; o.x = pk2(S0, S1); o.y = pk2(S2, S3); *(u32x2*)(base + (size_t)c * 16384) = o;
                S0 = dec * S0 + blo(uu[c].x); S1 = dec * S1 + bhi(uu[c].x); S2 = dec * S2 + blo(uu[c].y); S3 = dec * S3 + bhi(uu[c].y); } }
    }
}

__device__ __forceinline__ void fnet1_build_ct(LAS unsigned char* lds, int tid) {
    LAS bf16_t* Ct = (LAS bf16_t*)lds;
    for (int e = tid; e < 256 * 128; e += NTHR) { const int jp = e >> 7, m = e & 127, j = jp & 127; const float a = (float)((j * m) & 127) * (1.f / 128.f);
        Ct[jp * 136 + m] = f2bf(jp < 128 ? __builtin_amdgcn_cosf(a) : __builtin_amdgcn_sinf(a)); }
    __syncthreads();
}
__device__ __forceinline__ void fnet1_item(const Params& p, int item, LAS unsigned char* lds, int tid) {
    const int wave = tid >> 6, lane = tid & 63, fr = lane & 15, fq = lane >> 4;
    LAS bf16_t* Ct = (LAS bf16_t*)lds; LAS bf16_t* Up = (LAS bf16_t*)(lds + 69632); LAS bf16_t* Um = (LAS bf16_t*)(lds + 104448);
    const bf16_t* P = (const bf16_t*)(p.ws + OFF_P);
    int b, g, seq0, L, ld, n0; bf16_t* PQ;
    if (item < 256) { b = item >> 6; g = (item >> 4) & 3; const int t = item & 15; seq0 = b * SEQ; L = SEQ; ld = 4096; n0 = t * 128; PQ = (bf16_t*)(p.ws + OFF_PQ); }
    else { const int it = item - 256; b = it >> 2; g = it & 3; seq0 = NLAT + b * CTXL; L = CTXL; ld = 256; n0 = 0; PQ = (bf16_t*)(p.ws + OFF_PQC); }
    const int H = L >> 1;
#pragma unroll
    for (int w = 0; w < 4; ++w) { const int v = tid + w * NTHR, r = v >> 4, c8 = (v & 15) * 8, n = n0 + r;
        const u32x4 a = *(const u32x4*)(P + (size_t)(seq0 + n) * INC + C_F + g * 128 + c8);
        u32x4 m; m.x = 0; m.y = 0; m.z = 0; m.w = 0;
        if (n > 0) m = *(const u32x4*)(P + (size_t)(seq0 + L - n) * INC + C_F + g * 128 + c8);
        u32x4 op, om;
        op.x = pk2(blo(a.x) + blo(m.x), bhi(a.x) + bhi(m.x)); op.y = pk2(blo(a.y) + blo(m.y), bhi(a.y) + bhi(m.y)); op.z = pk2(blo(a.z) + blo(m.z), bhi(a.z) + bhi(m.z)); op.w = pk2(blo(a.w) + blo(m.w), bhi(a.w) + bhi(m.w));
        om.x = pk2(blo(a.x) - blo(m.x), bhi(a.x) - bhi(m.x)); om.y = pk2(blo(a.y) - blo(m.y), bhi(a.y) - bhi(m.y)); om.z = pk2(blo(a.z) - blo(m.z), bhi(a.z) - bhi(m.z)); om.w = pk2(blo(a.w) - blo(m.w), bhi(a.w) - bhi(m.w));
        if (n == 0) { om.x = 0; om.y = 0; om.z = 0; om.w = 0; }
        *(LAS u32x4*)(Up + r * 136 + c8) = op; *(LAS u32x4*)(Um + r * 136 + c8) = om; }
    __syncthreads();
    f32x4 acc[16];
#pragma unroll
    for (int i = 0; i < 16; ++i) acc[i] = (f32x4){0.f, 0.f, 0.f, 0.f};
#pragma unroll
    for (int ks = 0; ks < 4; ++ks) { const bf16x8 ap = *(const LAS bf16x8*)(Up + (wave * 16 + fr) * 136 + ks * 32 + fq * 8), am = *(const LAS bf16x8*)(Um + (wave * 16 + fr) * 136 + ks * 32 + fq * 8);
#pragma unroll
        for (int ct = 0; ct < 16; ++ct) { const bf16x8 bb = *(const LAS bf16x8*)(Ct + (ct * 16 + fr) * 136 + ks * 32 + fq * 8); acc[ct] = MFMA16(ct < 8 ? ap : am, bb, acc[ct]); } }
#pragma unroll
    for (int ct = 0; ct < 16; ++ct) { const int jp = ct * 16 + fr, jrow = jp & 127, off = (jp >> 7) * H;
        u32x2 o; o.x = pk2(acc[ct][0], acc[ct][1]); o.y = pk2(acc[ct][2], acc[ct][3]);
        bf16_t* dst = PQ + (size_t)((b * 4 + g) * 128 + jrow) * ld + off + n0 + wave * 16 + fq * 4;
        if (ct >= 8 && n0 == 0 && wave == 0 && fq == 0) { dst[1] = (bf16_t)(o.x >> 16); dst[2] = (bf16_t)(o.y & 0xffffu); dst[3] = (bf16_t)(o.y >> 16); }
        else *(u32x2*)dst = o; }
    if (n0 == 0 && tid < 128) {
        const int j = tid; float s = 0.f;
        for (int m = 0; m < 128; ++m) s += bf2f(P[(size_t)(seq0 + H) * INC + C_F + g * 128 + m]) * bf2f(Ct[j * 136 + m]);
        PQ[(size_t)((b * 4 + g) * 128 + j) * ld + H] = f2bf(s); }
    __syncthreads();
}

__device__ __forceinline__ void conv_item(const Params& p, int l, int item, LAS unsigned char* lds, int tid) {
    const int wave = tid >> 6, lane = tid & 63;
    const bf16_t* P = (const bf16_t*)(p.ws + OFF_P);
    bf16_t* Y = (bf16_t*)(p.ws + OFF_A);
    LAS bf16_t* Z = (LAS bf16_t*)lds;
    LAS float* O = (LAS float*)(lds + 63488);
    const int row0 = item * 32;
    int seq0, Ls;
    if (row0 < NLAT) { seq0 = (row0 >> 12) << 12; Ls = SEQ; } else { seq0 = NLAT + (((row0 - NLAT) >> 8) << 8); Ls = CTXL; }
    const int tpos0 = row0 - seq0;
    const int sch0 = (tid & 63) * 8, st0 = (tid >> 6) * 4;
    u32x4 scc[6], scx[6], scb[4];
#pragma unroll
    for (int r = 0; r < 6; ++r) { const int t2 = tpos0 + st0 + r - 1; scc[r] = (u32x4){0u, 0u, 0u, 0u}; scx[r] = scc[r];
        if (t2 >= 0 && t2 < Ls) { const bf16_t* rp = P + (size_t)(seq0 + t2) * INC; scc[r] = *(const u32x4*)(rp + C_SC + sch0); scx[r] = *(const u32x4*)(rp + C_SX + sch0); } }
#pragma unroll
    for (int q = 0; q < 4; ++q) scb[q] = *(const u32x4*)(P + (size_t)(seq0 + tpos0 + st0 + q) * INC + C_SB + sch0);
    {
        u32x4 za[8], zb[8];
#pragma unroll
        for (int it = 0; it < 8; ++it) { const int v = tid + it * NTHR, r = v >> 6, c8 = (v & 63) * 8, tp = tpos0 - 15 + r;
            za[it] = (u32x4){0u, 0u, 0u, 0u}; zb[it] = za[it];
            if (v < 62 * 64 && tp >= 0 && tp < Ls) { const bf16_t* rp = P + (size_t)(seq0 + tp) * INC; za[it] = *(const u32x4*)(rp + C_CA + c8); zb[it] = *(const u32x4*)(rp + C_CB + c8); } }
#pragma unroll
        for (int it = 0; it < 8; ++it) { const int v = tid + it * NTHR, r = v >> 6, c8 = (v & 63) * 8; const u32x4 a = za[it], bb = zb[it];
            u32x4 o;
            o.x = pk2(blo(a.x) * sigmoidf_(blo(bb.x)), bhi(a.x) * sigmoidf_(bhi(bb.x))); o.y = pk2(blo(a.y) * sigmoidf_(blo(bb.y)), bhi(a.y) * sigmoidf_(bhi(bb.y)));
            o.z = pk2(blo(a.z) * sigmoidf_(blo(bb.z)), bhi(a.z) * sigmoidf_(bhi(bb.z))); o.w = pk2(blo(a.w) * sigmoidf_(blo(bb.w)), bhi(a.w) * sigmoidf_(bhi(bb.w)));
            if (v < 62 * 64) *(LAS u32x4*)(Z + r * 512 + c8) = o; }
    }
    __syncthreads();
    const int ch = tid;
    {
        float w0[31];
#pragma unroll
        for (int w = 0; w < 31; ++w) w0[w] = p.cf_conv[(size_t)(l * 31 + w) * 512 + ch];
#pragma unroll 1
        for (int tg = 0; tg < 8; ++tg) { float a0 = 0.f, a1 = 0.f, a2 = 0.f, a3 = 0.f;
#pragma unroll
            for (int r = 0; r < 34; ++r) { const float zz = bf2f(Z[(tg * 4 + r) * 512 + ch]);
                if (r <= 30) a0 += zz * w0[r <= 30 ? r : 0];
                if (r >= 1 && r <= 31) a1 += zz * w0[(r >= 1 && r <= 31) ? r - 1 : 0];
                if (r >= 2 && r <= 32) a2 += zz * w0[(r >= 2 && r <= 32) ? r - 2 : 0];
                if (r >= 3) a3 += zz * w0[r >= 3 ? r - 3 : 0]; }
            O[(tg * 4 + 0) * 512 + ch] = a0; O[(tg * 4 + 1) * 512 + ch] = a1; O[(tg * 4 + 2) * 512 + ch] = a2; O[(tg * 4 + 3) * 512 + ch] = a3; }
    }
    {
        f32x4 wlo[3], whi[3];
#pragma unroll
        for (int w = 0; w < 3; ++w) { const float* wp = p.sc_conv + (size_t)(l * 3 + w) * 512 + sch0; wlo[w] = *(const f32x4*)wp; whi[w] = *(const f32x4*)(wp + 4); }
        f32x4 plo[6], phi[6];
#pragma unroll
        for (int r = 0; r < 6; ++r) { plo[r][0] = blo(scc[r].x) * blo(scx[r].x); plo[r][1] = bhi(scc[r].x) * bhi(scx[r].x); plo[r][2] = blo(scc[r].y) * blo(scx[r].y); plo[r][3] = bhi(scc[r].y) * bhi(scx[r].y);
            phi[r][0] = blo(scc[r].z) * blo(scx[r].z); phi[r][1] = bhi(scc[r].z) * bhi(scx[r].z); phi[r][2] = blo(scc[r].w) * blo(scx[r].w); phi[r][3] = bhi(scc[r].w) * bhi(scx[r].w); }
#pragma unroll
        for (int q = 0; q < 4; ++q) { const f32x4 alo = wlo[0] * plo[q] + wlo[1] * plo[q + 1] + wlo[2] * plo[q + 2], ahi = whi[0] * phi[q] + whi[1] * phi[q + 1] + whi[2] * phi[q + 2];
            u32x4 o; o.x = pk2(blo(scb[q].x) * alo[0], bhi(scb[q].x) * alo[1]); o.y = pk2(blo(scb[q].y) * alo[2], bhi(scb[q].y) * alo[3]);
            o.z = pk2(blo(scb[q].z) * ahi[0], bhi(scb[q].z) * ahi[1]); o.w = pk2(blo(scb[q].w) * ahi[2], bhi(scb[q].w) * ahi[3]);
            *(u32x4*)(Y + (size_t)(seq0 + tpos0 + st0 + q) * D + 1024 + sch0) = o; }
    }
    __syncthreads();
    {
        const float* lg = p.cf_ln + (size_t)(l * 2 + 0) * 512 + lane * 8; const float* lb = p.cf_ln + (size_t)(l * 2 + 1) * 512 + lane * 8;
        const f32x4 g0 = *(const f32x4*)lg, g1 = *(const f32x4*)(lg + 4), b0 = *(const f32x4*)lb, b1 = *(const f32x4*)(lb + 4);
#pragma unroll 1
        for (int q = 0; q < 4; ++q) { const int t = wave * 4 + q;
            f32x4 v0 = *(const LAS f32x4*)(O + t * 512 + lane * 8), v1 = *(const LAS f32x4*)(O + t * 512 + lane * 8 + 4);
            float s = v0[0] + v0[1] + v0[2] + v0[3] + v1[0] + v1[1] + v1[2] + v1[3]; s = wave_sum(s); const float mu = s * (1.f / 512.f);
            v0 = v0 - mu; v1 = v1 - mu;
            float q2 = v0[0] * v0[0] + v0[1] * v0[1] + v0[2] * v0[2] + v0[3] * v0[3] + v1[0] * v1[0] + v1[1] * v1[1] + v1[2] * v1[2] + v1[3] * v1[3]; q2 = wave_sum(q2);
            const float rs = rsqrtf(q2 * (1.f / 512.f) + EPS);
            v0 = v0 * rs * g0 + b0; v1 = v1 * rs * g1 + b1;
#pragma unroll
            for (int e = 0; e < 4; ++e) { v0[e] = v0[e] * sigmoidf_(v0[e]); v1[e] = v1[e] * sigmoidf_(v1[e]); }
            u32x4 o; o.x = pk2(v0[0], v0[1]); o.y = pk2(v0[2], v0[3]); o.z = pk2(v1[0], v1[1]); o.w = pk2(v1[2], v1[3]);
            *(u32x4*)(Y + (size_t)(row0 + t) * D + 1536 + lane * 8) = o; }
    }
    __syncthreads();
}

__device__ __forceinline__ void ret_item(const Params& p, int l, int item, LAS unsigned char* lds, int tid) {
    asm volatile("" : "+v"(tid));
    const int wave = tid >> 6, lane = tid & 63, fr = lane & 15, fq = lane >> 4;
    const bf16_t* P = (const bf16_t*)(p.ws + OFF_P);
    bf16_t* Y = (bf16_t*)(p.ws + OFF_A);
    const float* ropec = (const float*)(p.ws + OFF_ROPEC); const float* ropes = (const float*)(p.ws + OFF_ROPES);
    const bf16_t* Sg = (const bf16_t*)(p.ws + OFF_S); const bf16_t* Sc = (const bf16_t*)(p.ws + OFF_SCTX);
    int h, c, row0; bool rope, hasF, hasB; const bf16_t *SF, *SB;
    if (item < 512) { const int bh = item >> 5; c = item & 31; const int b = bh >> 2; h = bh & 3; row0 = b * SEQ + c * 128; rope = true; hasF = true; hasB = true;
        SF = Sg + ((size_t)bh * 32 + c) * 16384; SB = Sg + ((size_t)(16 + bh) * 32 + c) * 16384; }
    else { const int it = item - 512, bh = it >> 1; c = it & 1; const int b = bh >> 2; h = bh & 3; row0 = NLAT + b * CTXL + c * 128; rope = false; hasF = (c == 1); hasB = (c == 0);
        SF = Sc + ((size_t)(bh * 2 + 0) * 2 + 0) * 16384; SB = Sc + ((size_t)(bh * 2 + 1) * 2 + 1) * 16384; }
    const float LOG2E = 1.4426950408889634f;
    const float lf2 = log_sigmoid_(p.ret_decay[l * 8 + h]) * LOG2E, lb2 = log_sigmoid_(p.ret_decay[l * 8 + 4 + h]) * LOG2E;
    const float kscale = 0.08838834764831845f;
    LAS bf16_t* R0 = (LAS bf16_t*)lds; LAS bf16_t* R1 = (LAS bf16_t*)(lds + 34816); LAS bf16_t* R2 = (LAS bf16_t*)(lds + 69632); LAS bf16_t* R3 = (LAS bf16_t*)(lds + 104448);
    u32x4 rq1[2], rq2[2], rk1[2], rk2[2], rvv[4], rgt[4], rsf[4], rsb[4]; f32x4 c0[2], c1[2], s0[2], s1[2];
#pragma unroll
    for (int w = 0; w < 2; ++w) { const int wk = tid + w * NTHR, j = wk >> 3, d0 = (wk & 7) * 8;
        const bf16_t* qp = P + (size_t)(row0 + j) * INC + C_Q + h * 128 + d0; const bf16_t* kp = P + (size_t)(row0 + j) * INC + C_K + h * 128 + d0;
        rq1[w] = *(const u32x4*)qp; rq2[w] = *(const u32x4*)(qp + 64); rk1[w] = *(const u32x4*)kp; rk2[w] = *(const u32x4*)(kp + 64);
        c0[w] = (f32x4){1.f, 1.f, 1.f, 1.f}; c1[w] = c0[w]; s0[w] = (f32x4){0.f, 0.f, 0.f, 0.f}; s1[w] = s0[w];
        if (rope) { const int t = c * 128 + j; const float* cp = ropec + t * 64 + d0; const float* sp = ropes + t * 64 + d0; c0[w] = *(const f32x4*)cp; c1[w] = *(const f32x4*)(cp + 4); s0[w] = *(const f32x4*)sp; s1[w] = *(const f32x4*)(sp + 4); } }
#pragma unroll
    for (int w = 0; w < 4; ++w) { const int wk = tid + w * NTHR;
        { const int r = wk >> 4, c8 = (wk & 15) * 8;
          rsf[w] = (u32x4){0u, 0u, 0u, 0u}; rsb[w] = rsf[w];
          if (hasF) rsf[w] = *(const u32x4*)(SF + (size_t)r * 128 + c8);
          if (hasB) rsb[w] = *(const u32x4*)(SB + (size_t)r * 128 + c8); } }
#pragma unroll
    for (int w = 0; w < 2; ++w) { const int wk = tid + w * NTHR, j = wk >> 3, d0 = (wk & 7) * 8;
#pragma unroll
        for (int which = 0; which < 2; ++which) {
            const u32x4 r1 = which == 0 ? rq1[w] : rk1[w], r2 = which == 0 ? rq2[w] : rk2[w];
            const float scl = which == 0 ? 1.f : kscale;
            float k1[8], k2[8];
            k1[0] = blo(r1.x); k1[1] = bhi(r1.x); k1[2] = blo(r1.y); k1[3] = bhi(r1.y); k1[4] = blo(r1.z); k1[5] = bhi(r1.z); k1[6] = blo(r1.w); k1[7] = bhi(r1.w);
            k2[0] = blo(r2.x); k2[1] = bhi(r2.x); k2[2] = blo(r2.y); k2[3] = bhi(r2.y); k2[4] = blo(r2.z); k2[5] = bhi(r2.z); k2[6] = blo(r2.w); k2[7] = bhi(r2.w);
#pragma unroll
            for (int i = 0; i < 8; ++i) { const float cs = i < 4 ? c0[w][i & 3] : c1[w][i & 3], sn = i < 4 ? s0[w][i & 3] : s1[w][i & 3]; const float a = k1[i], bq = k2[i]; k1[i] = (a * cs - bq * sn) * scl; k2[i] = (a * sn + bq * cs) * scl; }
            u32x4 o1, o2; o1.x = pk2(k1[0], k1[1]); o1.y = pk2(k1[2], k1[3]); o1.z = pk2(k1[4], k1[5]); o1.w = pk2(k1[6], k1[7]);
            o2.x = pk2(k2[0], k2[1]); o2.y = pk2(k2[2], k2[3]); o2.z = pk2(k2[4], k2[5]); o2.w = pk2(k2[6], k2[7]);
            LAS bf16_t* dstb = which == 0 ? R0 : R1;
            *(LAS u32x4*)(dstb + j * 136 + d0) = o1; *(LAS u32x4*)(dstb + j * 136 + 64 + d0) = o2;
        }
    }
#pragma unroll
    for (int w = 0; w < 4; ++w) { const int wk = tid + w * NTHR, r = wk >> 4, c8 = (wk & 15) * 8; *(LAS u32x4*)(R2 + r * 136 + c8) = rsf[w]; *(LAS u32x4*)(R3 + r * 136 + c8) = rsb[w]; }
    __syncthreads();
#pragma unroll
    for (int w = 0; w < 4; ++w) { const int wk = tid + w * NTHR;
        { const int j = wk & 127, v0 = (wk >> 7) * 8; rvv[w] = *(const u32x4*)(P + (size_t)(row0 + j) * INC + C_V + h * 128 + v0); }
 }
    unsigned spk[8][2];
    {
    f32x4 sa[8];
#pragma unroll
    for (int i = 0; i < 8; ++i) sa[i] = (f32x4){0.f, 0.f, 0.f, 0.f};
#pragma unroll
    for (int kk = 0; kk < 4; ++kk) { const bf16x8 a = *(const LAS bf16x8*)(R0 + (wave * 16 + fr) * 136 + kk * 32 + fq * 8);
#pragma unroll
        for (int jt = 0; jt < 8; ++jt) { const bf16x8 bb = *(const LAS bf16x8*)(R1 + (jt * 16 + fr) * 136 + kk * 32 + fq * 8); sa[jt] = MFMA16(a, bb, sa[jt]); } }
#pragma unroll
    for (int jt = 0; jt < 8; ++jt) { float wv[4];
#pragma unroll
        for (int jj = 0; jj < 4; ++jj) { const int i = wave * 16 + fq * 4 + jj, j = jt * 16 + fr, df = i - j;
            const float wgt = df >= 0 ? __builtin_amdgcn_exp2f(lf2 * (float)df) : __builtin_amdgcn_exp2f(lb2 * (float)(-df)); wv[jj] = sa[jt][jj] * wgt; }
        spk[jt][0] = pk2(wv[0], wv[1]); spk[jt][1] = pk2(wv[2], wv[3]); }
    }
#pragma unroll
    for (int w = 0; w < 4; ++w) { const int wk = tid + w * NTHR, r = wk >> 4, c8 = (wk & 15) * 8; rgt[w] = *(const u32x4*)(P + (size_t)(row0 + r) * INC + C_G + h * 128 + c8); }
    f32x4 y[8];
#pragma unroll
    for (int i = 0; i < 8; ++i) y[i] = (f32x4){0.f, 0.f, 0.f, 0.f};
    if (hasF) {
        f32x4 t[8];
#pragma unroll
        for (int i = 0; i < 8; ++i) t[i] = (f32x4){0.f, 0.f, 0.f, 0.f};
#pragma unroll
        for (int kk = 0; kk < 4; ++kk) { const bf16x8 a = *(const LAS bf16x8*)(R0 + (wave * 16 + fr) * 136 + kk * 32 + fq * 8);
#pragma unroll
            for (int vt = 0; vt < 8; ++vt) { const bf16x8 bb = *(const LAS bf16x8*)(R2 + (vt * 16 + fr) * 136 + kk * 32 + fq * 8); t[vt] = MFMA16(a, bb, t[vt]); } }
#pragma unroll
        for (int jj = 0; jj < 4; ++jj) { const int i = wave * 16 + fq * 4 + jj; const float sc = __builtin_amdgcn_exp2f(lf2 * (float)(i + 1));
#pragma unroll
            for (int vt = 0; vt < 8; ++vt) y[vt][jj] += t[vt][jj] * sc; }
    }
    if (hasB) {
        f32x4 t[8];
#pragma unroll
        for (int i = 0; i < 8; ++i) t[i] = (f32x4){0.f, 0.f, 0.f, 0.f};
#pragma unroll
        for (int kk = 0; kk < 4; ++kk) { const bf16x8 a = *(const LAS bf16x8*)(R0 + (wave * 16 + fr) * 136 + kk * 32 + fq * 8);
#pragma unroll
            for (int vt = 0; vt < 8; ++vt) { const bf16x8 bb = *(const LAS bf16x8*)(R3 + (vt * 16 + fr) * 136 + kk * 32 + fq * 8); t[vt] = MFMA16(a, bb, t[vt]); } }
#pragma unroll
        for (int jj = 0; jj < 4; ++jj) { const int i = wave * 16 + fq * 4 + jj; const float sc = __builtin_amdgcn_exp2f(lb2 * (float)(128 - i));
#pragma unroll
            for (int vt = 0; vt < 8; ++vt) y[vt][jj] += t[vt][jj] * sc; }
    }
    __syncthreads();
#pragma unroll
    for (int jt = 0; jt < 8; ++jt) { const int i0 = wave * 16 + fq * 4, j = jt * 16 + fr;
        R2[(i0 + 0) * 136 + j] = (bf16_t)(spk[jt][0] & 0xffffu); R2[(i0 + 1) * 136 + j] = (bf16_t)(spk[jt][0] >> 16);
        R2[(i0 + 2) * 136 + j] = (bf16_t)(spk[jt][1] & 0xffffu); R2[(i0 + 3) * 136 + j] = (bf16_t)(spk[jt][1] >> 16); }
#pragma unroll
    for (int w = 0; w < 4; ++w) { const int wk = tid + w * NTHR;
        { const int j = wk & 127, v0 = (wk >> 7) * 8; const u32x4 rv = rvv[w];
          R3[(v0 + 0) * 136 + j] = (bf16_t)(rv.x & 0xffffu); R3[(v0 + 1) * 136 + j] = (bf16_t)(rv.x >> 16);
          R3[(v0 + 2) * 136 + j] = (bf16_t)(rv.y & 0xffffu); R3[(v0 + 3) * 136 + j] = (bf16_t)(rv.y >> 16);
          R3[(v0 + 4) * 136 + j] = (bf16_t)(rv.z & 0xffffu); R3[(v0 + 5) * 136 + j] = (bf16_t)(rv.z >> 16);
          R3[(v0 + 6) * 136 + j] = (bf16_t)(rv.w & 0xffffu); R3[(v0 + 7) * 136 + j] = (bf16_t)(rv.w >> 16); }
        { const int r = wk >> 4, c8 = (wk & 15) * 8; *(LAS u32x4*)(R1 + r * 136 + c8) = rgt[w]; } }
    __syncthreads();
#pragma unroll
    for (int kk = 0; kk < 4; ++kk) { const bf16x8 a = *(const LAS bf16x8*)(R2 + (wave * 16 + fr) * 136 + kk * 32 + fq * 8);
#pragma unroll
        for (int vt = 0; vt < 8; ++vt) { const bf16x8 bb = *(const LAS bf16x8*)(R3 + (vt * 16 + fr) * 136 + kk * 32 + fq * 8); y[vt] = MFMA16(a, bb, y[vt]); } }
#pragma unroll
    for (int jj = 0; jj < 4; ++jj) { const int i = wave * 16 + fq * 4 + jj;
        float s = 0.f;
#pragma unroll
        for (int vt = 0; vt < 8; ++vt) s += y[vt][jj];
        s += __shfl_xor(s, 1); s += __shfl_xor(s, 2); s += __shfl_xor(s, 4); s += __shfl_xor(s, 8);
        const float mu = s * (1.f / 128.f); float q2 = 0.f;
#pragma unroll
        for (int vt = 0; vt < 8; ++vt) { const float dv = y[vt][jj] - mu; q2 += dv * dv; }
        q2 += __shfl_xor(q2, 1); q2 += __shfl_xor(q2, 2); q2 += __shfl_xor(q2, 4); q2 += __shfl_xor(q2, 8);
        const float rs = rsqrtf(q2 * (1.f / 128.f) + EPS);
#pragma unroll
        for (int vt = 0; vt < 8; ++vt) { const int v = vt * 16 + fr; const float gt = bf2f(R1[i * 136 + v]);
            R0[i * 136 + v] = f2bf((y[vt][jj] - mu) * rs * gt * sigmoidf_(gt)); } }
    __syncthreads();
#pragma unroll
    for (int w = 0; w < 4; ++w) { const int wk = tid + w * NTHR, r = wk >> 4, c8 = (wk & 15) * 8;
        *(u32x4*)(Y + (size_t)(row0 + r) * D + h * 128 + c8) = *(const LAS u32x4*)(R0 + r * 136 + c8); }
    __syncthreads();
}

#define XB_TMO      128
#define XB_XCNT(j)  (256  + 64 * (j))
#define XB_XSUB(j)  (1280 + 64 * (j))
#define XB_XGEN(j)  (2304 + 64 * (j))
#define XB_TOP      3328
#define XB_TOPGEN   3392
#define XB_SPIN_CAP (1u << 18)
__device__ __forceinline__ unsigned xb_ld(unsigned* p)              { return __hip_atomic_load(p, __ATOMIC_RELAXED, __HIP_MEMORY_SCOPE_AGENT); }
__device__ __forceinline__ unsigned xb_add(unsigned* p, unsigned v) { return __hip_atomic_fetch_add(p, v, __ATOMIC_RELAXED, __HIP_MEMORY_SCOPE_AGENT); }
__device__ __forceinline__ unsigned xb_xcc_id() { return (unsigned)__builtin_amdgcn_s_getreg((3 << 11) | 20) & 0xFu; }
#define XB_SPIN(cond, bar) do { unsigned _sp = 0; while (cond) { __builtin_amdgcn_s_sleep(1); \
    if ((++_sp & 255u) == 0u) { if (xb_ld(&(bar)[XB_TMO])) break; if (_sp > XB_SPIN_CAP) { atomicAdd(&(bar)[XB_TMO], 1u); break; } } } } while (0)
struct XcdBarrier { unsigned* bar; unsigned x; volatile LAS unsigned* st; };
__device__ __forceinline__ XcdBarrier xcd_barrier_post(unsigned* bar, volatile LAS unsigned* st) {
    XcdBarrier b; b.bar = bar; b.x = xb_xcc_id(); b.st = st;
    if (threadIdx.x == 0) (void)xb_add(&bar[XB_XCNT(b.x)], 1u);
    return b;
}
__device__ __forceinline__ void xcd_barrier_complete(unsigned* bar, unsigned x, unsigned& nloc, unsigned& nx) {
    const unsigned G = gridDim.x * gridDim.y * gridDim.z;
    unsigned sum, cnt, mine, sp = 0u;
    for (;;) {
        sum = 0u; cnt = 0u; mine = 0u;
#pragma unroll
        for (unsigned j = 0; j < 16; ++j) { const unsigned c = xb_ld(&bar[XB_XCNT(j)]); sum += c; cnt += (c > 0u) ? 1u : 0u; mine = (j == x) ? c : mine; }
        if (sum == G) break;
        __builtin_amdgcn_s_sleep(1);
        if ((++sp & 255u) == 0u) { if (xb_ld(&bar[XB_TMO])) break; if (sp > XB_SPIN_CAP) { atomicAdd(&bar[XB_TMO], 1u); break; } }
    }
    nloc = mine > 0u ? mine : 1u; nx = cnt > 0u ? cnt : 1u;
}
__device__ __forceinline__ void xcd_barrier(const XcdBarrier& b) {
    asm volatile("s_waitcnt vmcnt(0)" ::: "memory");
    __syncthreads();
    if (threadIdx.x == 0) {
        unsigned* bar = b.bar;
        __builtin_amdgcn_s_waitcnt(0);
        unsigned nloc = b.st[0], nx = b.st[1];
        if (nloc == 0u) { xcd_barrier_complete(bar, b.x, nloc, nx); b.st[0] = nloc; b.st[1] = nx; }
        const unsigned old = xb_add(&bar[XB_XSUB(b.x)], 1u);
        const unsigned gen = old / nloc;
        if (old + 1u == (gen + 1u) * nloc) {
            __builtin_amdgcn_fence(__ATOMIC_RELEASE, "agent");
            asm volatile("s_waitcnt vmcnt(0)" ::: "memory");
            const unsigned og = xb_add(&bar[XB_TOP], 1u);
            const unsigned tg = og / nx;
            if (og + 1u == (tg + 1u) * nx) xb_add(&bar[XB_TOPGEN], 1u);
            else XB_SPIN(xb_ld(&bar[XB_TOPGEN]) == tg, bar);
            __builtin_amdgcn_fence(__ATOMIC_ACQUIRE, "agent");
            xb_add(&bar[XB_XGEN(b.x)], 1u);
            asm volatile("s_waitcnt vmcnt(0)" ::: "memory");
        } else {
            XB_SPIN(xb_ld(&bar[XB_XGEN(b.x)]) == gen, bar);
            __builtin_amdgcn_fence(__ATOMIC_ACQUIRE, "agent");
            asm volatile("s_waitcnt vmcnt(0)" ::: "memory");
        }
    }
    __syncthreads();
}

__device__ __forceinline__ void run_phase(const Params& p, int ph, LAS unsigned char* lds) {
    int tid = threadIdx.x; asm volatile("" : "+v"(tid));
    int blk = blockIdx.x, G = gridDim.x; asm volatile("" : "+s"(blk), "+s"(G));
    float* xc = (float*)(p.ws + OFF_XC);
    if (ph >= 22) return;
    if (ph == 0) { phase_A(p, lds, tid); return; }
    float* xbs = (float*)(p.ws + OFF_XB);
    if (ph == 21) { rowop(p, NLAT, xbs, xc, true, 1, 5, 3, true, p.out, xc, false, 0, 0, 0, 0, 0, tid, true, false); return; }
    const int l = (ph - 1) / 10; int s = (ph - 1) % 10;
    if (s == 3) { scan_phase(p, l, tid); return; }
    if (s > 3) --s;
    const int M_l = (l == 0) ? NROW : NLAT;
    bf16_t* Pb = (bf16_t*)(p.ws + OFF_P); bf16_t* Ab = (bf16_t*)(p.ws + OFF_A); float* Fb = (float*)(p.ws + OFF_F);
    if (s == 0) {
        if (l == 0) rowop(p, NROW, p.x, p.ctx, false, 0, 0, 0, false, nullptr, nullptr, true, 0, 0, 1, 0, 0, tid, false, false);
        else { rowop(p, NROW, xbs, xc, true, l - 1, 5, 3, true, xbs, xc, true, l, 0, 1, 0, 8, tid, true, true); convert_weights(p, l, lds, tid, G > 128 ? 6 : 31, blk, G); }
    } else if (s == 1 || s == 7) {
#pragma unroll 1
        for (int q = 0; q < 2; ++q) {
            pg8::Gemm g; pg8::Sched S; pg8::EpiBf16 E; E.zstride = 0; g.lda = D; g.ldb = D; g.K = D; g.zA = 0; g.zB = 0;
            if (s == 1) {
                g.Bt = (const bf16_t*)(p.ws + OFF_WIN); E.ldc = INC; E.act = 2;
                if (q == 0) { g.A = Ab; S.init(M_l, INC, 1, G, blk); E.O = Pb; }
                else { if (l == 0) break; g.A = Ab + (size_t)NLAT * D; S.init(NCTX, 1024, 1, G, blk >= G - 16 ? blk - (G - 16) : (1 << 20)); E.O = Pb + (size_t)NLAT * INC; }
            } else { if (q == 1) break; g.A = Ab; g.Bt = (const bf16_t*)(p.ws + OFF_WFF1); S.init(M_l, DFF, 1, G, blk); E.O = Pb; E.ldc = DFF; E.act = 1; }
            pg8::gemm_phase(lds, g, S, E, tid);
        }
        if (s == 1 && l == 0) gen_dft(p, lds, tid, blk, G);
        if (s == 7 && l == 0 && G > 128 && blk >= 128) convert_weights(p, 1, lds, tid, 25, blk - 128, G - 128);
    } else if (s == 2) {
        for (int it = blk; it < 544; it += G) ustate_item(p, l, it, lds, tid);
        const int nf = (l == 0) ? 272 : 256, b1 = (blk + G / 4) % G, b2 = (blk + G / 2) % G;
        if (b1 < nf) { fnet1_build_ct(lds, tid); for (int it = b1; it < nf; it += G) fnet1_item(p, it, lds, tid); }
        for (int it = b2; it < M_l / 32; it += G) conv_item(p, l, it, lds, tid);
    } else if (s == 3) {
#pragma unroll 1
        for (int q = 0; q < 2; ++q) {
            pg8::Gemm g; pg8::Sched S; pg8::EpiFnet E; g.zA = 0; g.zB = 0; E.Y = Ab;
            if (q == 0) { g.A = (const bf16_t*)(p.ws + OFF_DFTP); g.Bt = (const bf16_t*)(p.ws + OFF_PQ); g.lda = 4096; g.ldb = 4096; g.K = 4096; S.init(SEQ, 2048, 1, G, blk);
                E.rowbase = 0; E.Lseq = SEQ; E.scale = 0.0013810679320049757f; }
            else { if (l != 0) break; g.A = (const bf16_t*)(p.ws + OFF_DFTCP); g.Bt = (const bf16_t*)(p.ws + OFF_PQC); g.lda = 256; g.ldb = 256; g.K = 256;
                S.init(CTXL, 2048, 1, G, (G > 136 && blk >= 128) ? blk - 128 : blk);
                E.rowbase = NLAT; E.Lseq = CTXL; E.scale = 0.005524271728019903f; }
            pg8::gemm_phase(lds, g, S, E, tid);
        }
        int ob = blk, NOB = G;
        if (G > 128) { if (blk < 128) return; ob = blk - 128; NOB = G - 128; }
        const int nr = (l == 0) ? 544 : 512;
        for (int it = ob; it < nr; it += NOB) ret_item(p, l, it, lds, tid);
    } else if (s == 4) {
        pg8::Gemm g; pg8::Sched S; pg8::EpiGate E;
        g.A = Ab; g.Bt = (const bf16_t*)(p.ws + OFF_WBR); g.lda = D; g.ldb = D; g.K = 512; g.zA = 512; g.zB = 512; S.init(M_l, D, 4, G, blk);
        E.P = Pb;
        pg8::gemm_phase(lds, g, S, E, tid);
    } else if (s == 5 || s == 8) {
#pragma unroll 1
        for (int q = 0; q < 2; ++q) {
            pg8::Gemm g; pg8::Sched S; pg8::EpiBf16 E; E.ldc = D; E.act = 0;
            const int Kf = (s == 5) ? D : DFF, zK = (s == 5) ? 4 : 8;
            g.lda = (s == 5) ? INC : DFF; g.ldb = Kf; g.Bt = (const bf16_t*)(p.ws + (s == 5 ? OFF_WOUT : OFF_WFF2));
            if (q == 0) { g.A = Pb; g.K = Kf; g.zA = 0; g.zB = 0; S.init(NLAT, D, 1, G, blk); E.O = (bf16_t*)Fb; E.zstride = 0; }
            else { if (l != 0) break; g.A = Pb + (size_t)NLAT * g.lda; g.K = Kf / zK; g.zA = (size_t)(Kf / zK); g.zB = (size_t)(Kf / zK); S.init(NCTX, D * zK, 1, G, blk); S.zsplit = 8;
                E.O = (bf16_t*)(p.ws + OFF_PART); E.zstride = (size_t)NCTX * D; }
            pg8::gemm_phase(lds, g, S, E, tid);
        }
    } else if (s == 6) {
        if (l == 0) rowop(p, NROW, p.x, p.ctx, true, l, 2, 1, true, xbs, xc, true, l, 2, 4, 3, 4, tid, false, true);
        else rowop(p, NLAT, xbs, xc, true, l, 2, 1, true, xbs, xc, true, l, 2, 4, 3, 0, tid, true, true);
    }
}

__global__ __launch_bounds__(512, 2) void mega(Params p, int ph_lo, int ph_hi) {
    extern __shared__ __attribute__((aligned(16))) unsigned char shm[];
    LAS unsigned char* lds = (LAS unsigned char*)shm;
    cg::grid_group grid = cg::this_grid();
    volatile LAS unsigned* st = (volatile LAS unsigned*)(lds + 147392);
    if (threadIdx.x == 0) { st[0] = 0u; st[1] = 0u; }
    __syncthreads();
    (void)xcd_barrier_post((unsigned*)(p.ws + OFF_BAR), st);
    if (ph_lo < 0) grid.sync();
#if REP_T1 >= 0
    const int n_extra = (REP_T2 >= 0) ? 2 : 1;
#else
    const int n_extra = 0;
#endif
    for (int i = ph_lo; i < ph_hi + n_extra; ++i) {
        int ph = i;
#if REP_T1 >= 0
        ph = i - (i > REP_T1 ? 1 : 0) - ((REP_T2 >= 0 && i > REP_T2 + 1) ? 1 : 0);
#endif
        const __attribute__((address_space(4))) Params* pp = (const __attribute__((address_space(4))) Params*)__builtin_amdgcn_kernarg_segment_ptr();
        asm volatile("" : "+s"(pp));
        run_phase(*(const Params*)pp, ph, lds);
        if (i + 1 < ph_hi + n_extra) { XcdBarrier xb; xb.bar = (unsigned*)(((const Params*)pp)->ws + OFF_BAR); xb.x = xb_xcc_id(); xb.st = (volatile LAS unsigned*)(lds + 147392); xcd_barrier(xb); }
    }
}

extern "C" void kernel_launch(void* const* d_in, const int* in_sizes, int n_in, void* d_out, int out_size, void* d_ws, size_t ws_size, hipStream_t stream) {
    static int grid = 0;
    if (grid == 0) {
        if (n_in != 16 || ws_size < WS_END) { fprintf(stderr, "kernel_launch: need 16 inputs and %zu bytes of workspace; got %d, %zu\n", (size_t)WS_END, n_in, ws_size); grid = -1; return; }
        int dev = 0, cus = 0, per_cu = 0;
        if (hipGetDevice(&dev) != hipSuccess || hipDeviceGetAttribute(&cus, hipDeviceAttributeMultiprocessorCount, dev) != hipSuccess) { grid = -1; return; }
        if (hipFuncSetAttribute((const void*)mega, hipFuncAttributeMaxDynamicSharedMemorySize, LDS_BYTES) != hipSuccess) { fprintf(stderr, "kernel_launch: hipFuncSetAttribute failed\n"); grid = -1; return; }
        if (hipOccupancyMaxActiveBlocksPerMultiprocessor(&per_cu, (const void*)mega, NTHR, LDS_BYTES) != hipSuccess || per_cu < 1) { fprintf(stderr, "kernel_launch: occupancy query gave %d\n", per_cu); per_cu = 1; }
        (void)hipGetLastError();
        grid = cus * 1;
    }
    if (grid < 0) return;
    Params p{};
    p.x = (const float*)d_in[0]; p.c = (const float*)d_in[1]; p.ctx = (const float*)d_in[2]; p.cctx = (const float*)d_in[3];
    p.w_ada = (const float*)d_in[4]; p.b_ada = (const float*)d_in[5]; p.norm_g = (const float*)d_in[6]; p.w_in = (const float*)d_in[7];
    p.ret_decay = (const float*)d_in[8]; p.sc_conv = (const float*)d_in[9]; p.cf_conv = (const float*)d_in[10]; p.cf_ln = (const float*)d_in[11];
    p.w_branch = (const float*)d_in[12]; p.w_out = (const float*)d_in[13]; p.w_ff1 = (const float*)d_in[14]; p.w_ff2 = (const float*)d_in[15];
    p.out = (float*)d_out; p.ws = (unsigned char*)d_ws;
    if (hipMemsetAsync((char*)d_ws + OFF_BAR, 0, BAR_BYTES, stream) != hipSuccess) { fprintf(stderr, "kernel_launch: memset of the barrier words failed\n"); return; }
    int lo = 0, hi = 22 + NULL_PHASES;
    void* args[] = {&p, &lo, &hi};
    hipError_t e = hipLaunchCooperativeKernel((const void*)mega, dim3(grid), dim3(NTHR), args, LDS_BYTES, stream);
    if (e != hipSuccess) fprintf(stderr, "cooperative launch failed: %s (grid %d)\n", hipGetErrorString(e), grid);
}
```

```cpp
#include <hip/hip_runtime.h>
#include <hip/hip_cooperative_groups.h>
#include <cstdio>
namespace cg = cooperative_groups;
#ifndef NULL_PHASES
#define NULL_PHASES 0
#endif
#ifndef REP_T1
#define REP_T1 -1
#endif
#ifndef REP_T2
#define REP_T2 -1
#endif

#define LAS __attribute__((address_space(3)))
typedef unsigned short bf16_t;
typedef short bf16x8 __attribute__((ext_vector_type(8)));
typedef float f32x4 __attribute__((ext_vector_type(4)));
typedef unsigned u32x4 __attribute__((ext_vector_type(4)));
typedef unsigned u32x2 __attribute__((ext_vector_type(2)));

constexpr int D = 2048, NB = 4, SEQ = 4096, NLAT = NB * SEQ, CTXL = 256, NCTX = NB * CTXL, NROW = NLAT + NCTX;
constexpr int INC = 13312, DFF = 8192;
constexpr int C_K = 0, C_V = 512, C_Q = 1024, C_G = 1536, C_F = 2048, C_SB = 2560, C_SC = 3072, C_SX = 3584, C_CA = 4096, C_CB = 4608, C_GATE = 5120;
constexpr float EPS = 1e-6f;
constexpr int LDS_BYTES = 147456;
constexpr int NTHR = 512;

constexpr size_t SZ_WIN = (size_t)INC * D * 2, SZ_WFF = (size_t)DFF * D * 2, SZ_WOUT = (size_t)D * D * 2, SZ_WBR = (size_t)4 * D * 512 * 2;
constexpr size_t OFF_WIN = 0, OFF_WFF1 = OFF_WIN + SZ_WIN, OFF_WFF2 = OFF_WFF1 + SZ_WFF, OFF_WOUT = OFF_WFF2 + SZ_WFF, OFF_WBR = OFF_WOUT + SZ_WOUT;
constexpr size_t OFF_P = OFF_WBR + SZ_WBR;
constexpr size_t SZ_P = (size_t)NROW * INC * 2;
constexpr size_t OFF_A = OFF_P + SZ_P;
constexpr size_t SZ_A = (size_t)NROW * D * 2;
constexpr size_t OFF_F = OFF_A + SZ_A;
constexpr size_t SZ_F = (size_t)NROW * D * 4;
constexpr size_t OFF_S = OFF_F;
constexpr size_t OFF_PQ = OFF_S + (size_t)2 * 16 * 32 * 16384 * 2;
constexpr size_t OFF_DFT = OFF_PQ + (size_t)2048 * 8192 * 2;
constexpr size_t OFF_SCTX = OFF_DFT + (size_t)4096 * 8192 * 2;
constexpr size_t OFF_PQC = OFF_SCTX + (size_t)16 * 2 * 2 * 16384 * 2;
constexpr size_t OFF_DFTC = OFF_PQC + (size_t)2048 * 512 * 2;
constexpr size_t OFF_FEND = OFF_DFTC + (size_t)256 * 512 * 2;
static_assert(OFF_FEND <= OFF_F + SZ_F, "alias overflow");
constexpr size_t OFF_XB = OFF_F + (size_t)NLAT * D * 2;
static_assert(OFF_XB + (size_t)NLAT * D * 2 <= OFF_SCTX, "residual stream overlaps the context state area");
constexpr size_t OFF_XC = OFF_F + SZ_F;
constexpr size_t OFF_MOD = OFF_XC + (size_t)NCTX * D * 4;
constexpr size_t OFF_ROPEC = OFF_MOD + (size_t)2 * 5 * 12288 * 4;
constexpr size_t OFF_ROPES = OFF_ROPEC + (size_t)4096 * 64 * 4;
constexpr size_t OFF_PART = OFF_ROPES + (size_t)4096 * 64 * 4;
constexpr size_t OFF_DFTP = OFF_PART + (size_t)8 * NCTX * D * 2;
constexpr size_t OFF_BAR = OFF_PART + (size_t)8 * NCTX * D * 4;
constexpr size_t BAR_BYTES = 3456 * 4;
constexpr size_t OFF_DFTCP = OFF_BAR + BAR_BYTES;
constexpr size_t WS_END = OFF_DFTCP + (size_t)256 * 256 * 2;

struct Params {
    const float *x, *c, *ctx, *cctx, *w_ada, *b_ada, *norm_g, *w_in, *ret_decay, *sc_conv, *cf_conv, *cf_ln, *w_branch, *w_out, *w_ff1, *w_ff2;
    float* out;
    unsigned char* ws;
};

__device__ __forceinline__ float bf2f(bf16_t b) { return __uint_as_float(((unsigned)b) << 16); }
__device__ __forceinline__ unsigned pk2(float lo, float hi) { unsigned r; asm volatile("v_cvt_pk_bf16_f32 %0, %1, %2" : "=v"(r) : "v"(lo), "v"(hi)); return r; }
__device__ __forceinline__ bf16_t f2bf(float f) { return (bf16_t)(pk2(f, 0.f) & 0xffffu); }
__device__ __forceinline__ float blo(unsigned u) { return __uint_as_float(u << 16); }
__device__ __forceinline__ float bhi(unsigned u) { return __uint_as_float(u & 0xffff0000u); }
__device__ __forceinline__ float wave_sum(float v) {
#pragma unroll
    for (int o = 1; o < 64; o <<= 1) v += __shfl_xor(v, o);
    return v;
}
__device__ __forceinline__ float sigmoidf_(float x) { return __builtin_amdgcn_rcpf(1.f + __expf(-x)); }
__device__ __forceinline__ float log_sigmoid_(float x) {
    const float e = __expf(-x);
    return e < 0.06f ? -(e * (1.f + e * (-0.5f + e * (0.33333333f + e * (-0.25f + e * 0.2f))))) : -__logf(1.f + e); }
#define MFMA16(a, b, c) __builtin_amdgcn_mfma_f32_16x16x32_bf16((a), (b), (c), 0, 0, 0)

namespace pg8 {
constexpr int BM = 256, BK = 64, HALF = 128, HTB = HALF * BK * 2, STAGE_BYTES = 8 * HTB, NXCD = 8, WGM = 8;
__device__ __forceinline__ int lds_byte(int r, int c) { const int st = (r >> 4) * 2 + (c >> 5), rr = r & 15, cc = c & 31, ob = rr * 64 + cc * 2; return st * 1024 + (ob ^ (((ob >> 9) & 1) << 5)); }
__device__ __forceinline__ void stage_rc(int b, int& R, int& C) { const int st = b / 1024, sb = b % 1024, swz = sb ^ (((sb >> 9) & 1) << 5); R = (st >> 1) * 16 + swz / 64; C = (st & 1) * 32 + (swz % 64) / 2; }
__device__ __forceinline__ int perm32(int rho) { const int n = rho >> 4, i = rho & 15; return 8 * (i >> 2) + 4 * n + (i & 3); }

struct Unit { int pm, pn, z; };
struct Gemm { const bf16_t* A; const bf16_t* Bt; int lda, ldb, K; size_t zA, zB; };

struct Sched {
    int nM, nN, nZ, nwg, G, c, zsplit;
    __device__ __forceinline__ void init(int M, int N, int Z, int G_, int c_) { nM = M / BM; nN = N / BM; nZ = Z; nwg = nM * nN; G = G_; c = c_; zsplit = 0; }
    __device__ __forceinline__ bool next(int i, Unit& u) const {
        const int ti = i / nZ; u.z = i - ti * nZ;
        const long L = (long)ti * G + c; if (L >= nwg) return false;
        int wgid = (int)L; { const int q = nwg / NXCD, r = nwg % NXCD, xcd = wgid % NXCD, off = wgid / NXCD; wgid = (xcd < r ? xcd * (q + 1) : r * (q + 1) + (xcd - r) * q) + off; }
        const int nig = WGM * nN, gid = wgid / nig, fm = gid * WGM, gsz = (nM - fm) < WGM ? (nM - fm) : WGM;
        u.pm = fm + ((wgid % nig) % gsz); u.pn = (wgid % nig) / gsz;
        if (zsplit) { u.z = u.pn / zsplit; u.pn -= u.z * zsplit; }
        return true;
    }
};

struct EpiBf16 {
    static constexpr bool PERM = true, CHAIN = false;
    bf16_t* O; int ldc; int act; size_t zstride;
    __device__ __forceinline__ void operator()(f32x4 (&acc)[2][2][4][2], const Unit& u, int wr, int wc, int fr, int fq) const {
        const int row0 = u.pm * BM + wr * 64 + fr, col0 = u.pn * BM + wc * 32 + 8 * fq;
        if ((act == 2) && (u.pn * BM >= C_GATE)) {
#pragma unroll
            for (int ai = 0; ai < 2; ++ai)
#pragma unroll
                for (int m = 0; m < 4; ++m) { bf16_t* gp = O + (size_t)(row0 + ai * HALF + m * 16) * ldc + C_GATE + ((col0 - C_GATE) >> 1);
#pragma unroll
                    for (int bj = 0; bj < 2; ++bj) { const f32x4 v0 = acc[ai][bj][m][0], v1 = acc[ai][bj][m][1];
                        u32x2 o; o.x = 0u; o.y = 0u;
#pragma unroll
                        for (int e = 0; e < 4; ++e) {
                            o.x = __builtin_amdgcn_cvt_pk_u8_f32(fmaxf(__builtin_rintf(255.f * __builtin_amdgcn_rcpf(1.f + __expf(-v0[e]))), 1.f), (unsigned)e, o.x);
                            o.y = __builtin_amdgcn_cvt_pk_u8_f32(fmaxf(__builtin_rintf(255.f * __builtin_amdgcn_rcpf(1.f + __expf(-v1[e]))), 1.f), (unsigned)e, o.y); }
                        *(u32x2*)(gp + bj * (HALF / 2)) = o; } }
            return;
        }
#pragma unroll
        for (int ai = 0; ai < 2; ++ai)
#pragma unroll
            for (int m = 0; m < 4; ++m) { bf16_t* rowp = O + (size_t)u.z * zstride + (size_t)(row0 + ai * HALF + m * 16) * ldc + col0;
#pragma unroll
                for (int bj = 0; bj < 2; ++bj) { f32x4 v0 = acc[ai][bj][m][0], v1 = acc[ai][bj][m][1];
                    if (act == 1) {
#pragma unroll
                        for (int e = 0; e < 4; ++e) { float a = fmaxf(v0[e], 0.f), b = fmaxf(v1[e], 0.f); v0[e] = a * a; v1[e] = b * b; } }
                    u32x4 o; o.x = pk2(v0[0], v0[1]); o.y = pk2(v0[2], v0[3]); o.z = pk2(v1[0], v1[1]); o.w = pk2(v1[2], v1[3]);
                    *(u32x4*)(rowp + bj * HALF) = o; } }
    }
};
struct EpiF32 {
    static constexpr bool PERM = false, CHAIN = false;
    float* C; int ldc; size_t zstride;
    __device__ __forceinline__ void operator()(f32x4 (&acc)[2][2][4][2], const Unit& u, int wr, int wc, int fr, int fq) const {
        const int row0 = u.pm * BM + wr * 64 + fr, col0 = u.pn * BM + wc * 32 + 4 * fq;
#pragma unroll
        for (int ai = 0; ai < 2; ++ai)
#pragma unroll
            for (int m = 0; m < 4; ++m) { float* rowp = C + (size_t)u.z * zstride + (size_t)(row0 + ai * HALF + m * 16) * ldc + col0;
#pragma unroll
                for (int bj = 0; bj < 2; ++bj)
#pragma unroll
                    for (int n = 0; n < 2; ++n) *(f32x4*)(rowp + bj * HALF + n * 16) = acc[ai][bj][m][n]; }
    }
};
struct EpiGate {
    static constexpr bool PERM = true, CHAIN = true;
    bf16_t* P;
    __device__ __forceinline__ void ratio8(f32x4& v0, f32x4& v1, const u32x4 ga, const u32x4 gb) const {
        v0[0] *= (1.f + __expf(-blo(gb.x))) * __builtin_amdgcn_rcpf(1.f + __expf(-blo(ga.x))); v0[1] *= (1.f + __expf(-bhi(gb.x))) * __builtin_amdgcn_rcpf(1.f + __expf(-bhi(ga.x)));
        v0[2] *= (1.f + __expf(-blo(gb.y))) * __builtin_amdgcn_rcpf(1.f + __expf(-blo(ga.y))); v0[3] *= (1.f + __expf(-bhi(gb.y))) * __builtin_amdgcn_rcpf(1.f + __expf(-bhi(ga.y)));
        v1[0] *= (1.f + __expf(-blo(gb.z))) * __builtin_amdgcn_rcpf(1.f + __expf(-blo(ga.z))); v1[1] *= (1.f + __expf(-bhi(gb.z))) * __builtin_amdgcn_rcpf(1.f + __expf(-bhi(ga.z)));
        v1[2] *= (1.f + __expf(-blo(gb.w))) * __builtin_amdgcn_rcpf(1.f + __expf(-blo(ga.w))); v1[3] *= (1.f + __expf(-bhi(gb.w))) * __builtin_amdgcn_rcpf(1.f + __expf(-bhi(ga.w))); }
    __device__ __forceinline__ void gate8(f32x4& v0, f32x4& v1, const u32x4 g) const {
        v0[0] *= sigmoidf_(blo(g.x)); v0[1] *= sigmoidf_(bhi(g.x)); v0[2] *= sigmoidf_(blo(g.y)); v0[3] *= sigmoidf_(bhi(g.y));
        v1[0] *= sigmoidf_(blo(g.z)); v1[1] *= sigmoidf_(bhi(g.z)); v1[2] *= sigmoidf_(blo(g.w)); v1[3] *= sigmoidf_(bhi(g.w)); }
    __device__ __forceinline__ void step8(f32x4& v0, f32x4& v1, const u32x2 ga, const u32x2 gb, const bool last, u32x4& o) const {
        float s[8], t[8];
#pragma unroll
        for (int e = 0; e < 4; ++e) { s[e] = (float)((ga.x >> (8 * e)) & 0xffu); s[4 + e] = (float)((ga.y >> (8 * e)) & 0xffu); t[e] = (float)((gb.x >> (8 * e)) & 0xffu); t[4 + e] = (float)((gb.y >> (8 * e)) & 0xffu); }
        float r[8];
#pragma unroll
        for (int e = 0; e < 8; ++e) { s[e] = s[e] * (1.f / 255.f); t[e] = last ? 0.f : 255.f * __builtin_amdgcn_rcpf(t[e]); }
#pragma unroll
        for (int e = 0; e < 4; ++e) { r[e] = v0[e] * s[e]; r[4 + e] = v1[e] * s[4 + e]; }
        o.x = pk2(r[0], r[1]); o.y = pk2(r[2], r[3]); o.z = pk2(r[4], r[5]); o.w = pk2(r[6], r[7]);
#pragma unroll
        for (int e = 0; e < 4; ++e) { v0[e] = r[e] * t[e]; v1[e] = r[4 + e] * t[4 + e]; }
    }
    __device__ __forceinline__ void operator()(f32x4 (&acc)[2][2][4][2], const Unit& u, int wr, int wc, int fr, int fq) const {
        const int row0 = u.pm * BM + wr * 64 + fr, col0 = u.pn * BM + wc * 32 + 8 * fq, z = u.z;
        const bool last = (z == 3); const int dz = last ? 0 : D / 2;
        u32x2 ga[16], gb[16];
#pragma unroll
        for (int ch = 0; ch < 8; ++ch) { const size_t row = (size_t)(row0 + (ch >> 2) * HALF + (ch & 3) * 16);
#pragma unroll
            for (int bj = 0; bj < 2; ++bj) { const bf16_t* gp = P + row * INC + C_GATE + ((z * D + col0 + bj * HALF) >> 1); ga[ch * 2 + bj] = *(const u32x2*)gp; gb[ch * 2 + bj] = *(const u32x2*)(gp + dz); } }
#pragma unroll
        for (int ch = 0; ch < 8; ++ch) { const int ai = ch >> 2, m = ch & 3; const size_t row = (size_t)(row0 + ai * HALF + m * 16);
#pragma unroll
            for (int bj = 0; bj < 2; ++bj) { u32x4 o; step8(acc[ai][bj][m][0], acc[ai][bj][m][1], ga[ch * 2 + bj], gb[ch * 2 + bj], last, o);
                if (last) *(u32x4*)(P + row * INC + col0 + bj * HALF) = o; }
        }
    }
};
struct EpiFnet {
    static constexpr bool PERM = true, CHAIN = false;
    bf16_t* Y; int rowbase, Lseq; float scale;
    __device__ __forceinline__ void operator()(f32x4 (&acc)[2][2][4][2], const Unit& u, int wr, int wc, int fr, int fq) const {
        const int row0 = u.pm * BM + wr * 64 + fr, col0 = u.pn * BM + wc * 32 + 8 * fq;
#pragma unroll
        for (int ai = 0; ai < 2; ++ai)
#pragma unroll
            for (int m = 0; m < 4; ++m) { const int k = row0 + ai * HALF + m * 16;
#pragma unroll
                for (int bj = 0; bj < 2; ++bj) { const int n8 = col0 + bj * HALF; const int bg = n8 >> 7, j = n8 & 127, b = bg >> 2, g = bg & 3;
                    const f32x4 v0 = acc[ai][bj][m][0] * scale, v1 = acc[ai][bj][m][1] * scale;
                    u32x4 o; o.x = pk2(v0[0], v0[1]); o.y = pk2(v0[2], v0[3]); o.z = pk2(v1[0], v1[1]); o.w = pk2(v1[2], v1[3]);
                    *(u32x4*)(Y + (size_t)(rowbase + b * Lseq + k) * D + 512 + g * 128 + j) = o; } }
    }
};

template <class Epi>
__device__ __forceinline__ void gemm_phase(LAS unsigned char* lds, const Gemm g, const Sched& S, const Epi& E, const int tid) {
    const int wid = __builtin_amdgcn_readfirstlane(tid >> 6), lane = tid & 63, wr = wid >> 2, wc = wid & 3, fr = lane & 15, fq = lane >> 4;
    const int K = g.K, nt = K / BK;
    unsigned voffA[2], voffB[2];
#pragma unroll
    for (int i = 0; i < 2; ++i) { int R, C; stage_rc(tid * 16 + i * 8192, R, C); const int Rb = Epi::PERM ? ((R & ~31) + perm32(R & 31)) : R;
        voffA[i] = (unsigned)(R * g.lda + C) * 2u; voffB[i] = (unsigned)(Rb * g.ldb + C) * 2u; }
    const size_t kstep = (size_t)(BK * 2);
    const size_t hstepA = (size_t)HALF * g.lda * 2, hstepB = (size_t)HALF * g.ldb * 2;
    const size_t tstepA = 2 * hstepA, tstepB = 2 * hstepB;
    const unsigned ldsw = (unsigned)wid * 1024u;
    const int aoff = lds_byte(wr * 64 + fr, fq * 8), boff = lds_byte(wc * 32 + fr, fq * 8);
#define PG8_SA(b, h) (((b) * 2 + (h)) * HTB)
#define PG8_SB(b, h) ((4 + (b) * 2 + (h)) * HTB)
#define PG8_STAGE(bufoff, gbase, voff) do { _Pragma("unroll") for (int _i = 0; _i < 2; ++_i) \
        __builtin_amdgcn_global_load_lds((const unsigned*)((const char*)(gbase) + (voff)[_i]), (LAS unsigned*)(lds + (bufoff) + ldsw + _i * 8192), 16, 0, 0); } while (0)
#define PG8_LDA(dst, b, h) do { _Pragma("unroll") for (int m = 0; m < 4; ++m) _Pragma("unroll") for (int k = 0; k < 2; ++k) dst[m][k] = *(const LAS bf16x8*)(lds + PG8_SA(b, h) + aoff + m * 2048 + k * 1024); } while (0)
#define PG8_LDB(dst, b, h) do { _Pragma("unroll") for (int n = 0; n < 2; ++n) _Pragma("unroll") for (int k = 0; k < 2; ++k) dst[n][k] = *(const LAS bf16x8*)(lds + PG8_SB(b, h) + boff + n * 2048 + k * 1024); } while (0)
#define PG8_MMA(ai, bj, At, Bt) do { __builtin_amdgcn_s_setprio(1); _Pragma("unroll") for (int m = 0; m < 4; ++m) _Pragma("unroll") for (int n = 0; n < 2; ++n) _Pragma("unroll") for (int k = 0; k < 2; ++k) \
        acc[ai][bj][m][n] = __builtin_amdgcn_mfma_f32_16x16x32_bf16(Bt[n][k], At[m][k], acc[ai][bj][m][n], 0, 0, 0); __builtin_amdgcn_s_setprio(0); } while (0)
#define PG8_WAIT_V(n) asm volatile("s_waitcnt vmcnt(" #n ")" ::: "memory")
#define PG8_WAIT_L(n) asm volatile("s_waitcnt lgkmcnt(" #n ")" ::: "memory")
#define PG8_BAR __builtin_amdgcn_s_barrier()
#define PG8_SCHED __builtin_amdgcn_sched_barrier(0)
    Unit cur, nxt; int ui = 0;
    if (!S.next(0, cur)) return;
    f32x4 acc[2][2][4][2];
#pragma unroll
    for (int a = 0; a < 2; ++a)
#pragma unroll
        for (int b = 0; b < 2; ++b)
#pragma unroll
            for (int m = 0; m < 4; ++m)
#pragma unroll
                for (int n = 0; n < 2; ++n) acc[a][b][m][n] = (f32x4){0.f, 0.f, 0.f, 0.f};
    bf16x8 At[4][2], B0[2][2], B1[2][2];
    const char* cA = (const char*)g.A + ((size_t)cur.z * g.zA) * 2 + (size_t)cur.pm * tstepA;
    const char* cB = (const char*)g.Bt + ((size_t)cur.z * g.zB) * 2 + (size_t)cur.pn * tstepB;
    PG8_STAGE(PG8_SB(0, 0), cB, voffB); PG8_STAGE(PG8_SA(0, 0), cA, voffA); PG8_STAGE(PG8_SB(0, 1), cB + hstepB, voffB); PG8_STAGE(PG8_SA(0, 1), cA + hstepA, voffA);
    if (wr == 1) PG8_BAR;
    PG8_WAIT_V(4); PG8_BAR;
    PG8_STAGE(PG8_SB(1, 0), cB + kstep, voffB); PG8_STAGE(PG8_SA(1, 0), cA + kstep, voffA); PG8_STAGE(PG8_SB(1, 1), cB + hstepB + kstep, voffB);
    PG8_WAIT_V(6); PG8_BAR;
    for (;;) {
        const bool has_next = S.next(ui + 1, nxt);
        const char* nA = has_next ? (const char*)g.A + ((size_t)nxt.z * g.zA) * 2 + (size_t)nxt.pm * tstepA : cA;
        const char* nB = has_next ? (const char*)g.Bt + ((size_t)nxt.z * g.zB) * 2 + (size_t)nxt.pn * tstepB : cB;
        for (int t = 0; t < nt; t += 2) {
            const bool last = (t == nt - 2);
            const char* a1 = cA + (size_t)(t + 1) * kstep;
            const char* a2 = last ? nA : cA + (size_t)(t + 2) * kstep; const char* b2 = last ? nB : cB + (size_t)(t + 2) * kstep;
            const char* a3 = a2 + kstep; const char* b3 = b2 + kstep;
            PG8_LDB(B0, 0, 0); PG8_SCHED; PG8_LDA(At, 0, 0); PG8_STAGE(PG8_SA(1, 1), a1 + hstepA, voffA);
            PG8_WAIT_L(8); PG8_BAR; PG8_WAIT_L(0); PG8_MMA(0, 0, At, B0); PG8_BAR; PG8_SCHED;
            PG8_LDB(B1, 0, 1); PG8_STAGE(PG8_SB(0, 0), b2, voffB);
            PG8_BAR; PG8_WAIT_L(0); PG8_MMA(0, 1, At, B1); PG8_BAR;
            PG8_LDA(At, 0, 1); PG8_STAGE(PG8_SA(0, 0), a2, voffA);
            PG8_BAR; PG8_WAIT_L(0); PG8_MMA(1, 0, At, B0); PG8_BAR; PG8_SCHED;
            PG8_STAGE(PG8_SB(0, 1), b2 + hstepB, voffB);
            PG8_WAIT_V(6); PG8_BAR; PG8_MMA(1, 1, At, B1); PG8_BAR;
            PG8_LDB(B0, 1, 0); PG8_SCHED; PG8_LDA(At, 1, 0); PG8_STAGE(PG8_SA(0, 1), a2 + hstepA, voffA);
            PG8_WAIT_L(8); PG8_BAR; PG8_WAIT_L(0); PG8_MMA(0, 0, At, B0); PG8_BAR; PG8_SCHED;
            PG8_LDB(B1, 1, 1); PG8_STAGE(PG8_SB(1, 0), b3, voffB);
            PG8_BAR; PG8_WAIT_L(0); PG8_MMA(0, 1, At, B1); PG8_BAR;
            PG8_LDA(At, 1, 1); PG8_STAGE(PG8_SA(1, 0), a3, voffA);
            PG8_BAR; PG8_WAIT_L(0); PG8_MMA(1, 0, At, B0); PG8_BAR; PG8_SCHED;
            PG8_STAGE(PG8_SB(1, 1), b3 + hstepB, voffB);
            PG8_WAIT_V(6); PG8_BAR; PG8_MMA(1, 1, At, B1); PG8_BAR;
        }
        E(acc, cur, wr, wc, fr, fq);
        if (!has_next) break;
        if constexpr (!Epi::CHAIN)
#pragma unroll
        for (int a = 0; a < 2; ++a)
#pragma unroll
            for (int b = 0; b < 2; ++b)
#pragma unroll
                for (int m = 0; m < 4; ++m)
#pragma unroll
                    for (int n = 0; n < 2; ++n) acc[a][b][m][n] = (f32x4){0.f, 0.f, 0.f, 0.f};
        cur = nxt; cA = nA; cB = nB; ++ui;
    }
    PG8_WAIT_V(0);
    if (wr == 0) PG8_BAR;
    PG8_BAR;
#undef PG8_SA
#undef PG8_SB
#undef PG8_STAGE
#undef PG8_LDA
#undef PG8_LDB
#undef PG8_MMA
#undef PG8_WAIT_V
#undef PG8_WAIT_L
#undef PG8_BAR
#undef PG8_SCHED
}
}

__device__ __forceinline__ void transpose_item(const float* W, int K, int N, bf16_t* WT, LAS float* scr, int item, int lane, int ldw) {
    const int nblk = N / 64, kb = item / nblk, nb = item % nblk, k0 = 64 * kb, n0 = 64 * nb;
    f32x4 w[16];
#pragma unroll
    for (int i = 0; i < 16; ++i) { const int kk = 4 * i + (lane >> 4); w[i] = __builtin_nontemporal_load((const f32x4*)(W + (size_t)(k0 + kk) * N + n0 + (lane & 15) * 4)); }
#pragma unroll
    for (int i = 0; i < 16; ++i) { const int kk = 4 * i + (lane >> 4); LAS float* d = scr + kk * 65 + (lane & 15) * 4; d[0] = w[i][0]; d[1] = w[i][1]; d[2] = w[i][2]; d[3] = w[i][3]; }
    asm volatile("s_waitcnt lgkmcnt(0)" ::: "memory");
    const int c = lane & 7;
#pragma unroll
    for (int j = 0; j < 8; ++j) { const int n = (lane >> 3) + 8 * j; const LAS float* s = scr + (8 * c) * 65 + n;
        u32x4 o; o.x = pk2(s[0 * 65], s[1 * 65]); o.y = pk2(s[2 * 65], s[3 * 65]); o.z = pk2(s[4 * 65], s[5 * 65]); o.w = pk2(s[6 * 65], s[7 * 65]);
        *(u32x4*)(WT + (size_t)(n0 + n) * ldw + k0 + 8 * c) = o; }
    asm volatile("s_waitcnt lgkmcnt(0)" ::: "memory");
}
__device__ __forceinline__ void convert_weights(const Params& p, int l, LAS unsigned char* lds, int tid, int mask, int vb, int nvb) {
    const int wave = tid >> 6, lane = tid & 63;
    LAS float* scr = (LAS float*)(lds + wave * 16640);
    const int gw = vb * 8 + wave, NGW = nvb * 8;
    constexpr int I_IN = (D / 64) * (INC / 64), I_F1 = (D / 64) * (DFF / 64), I_F2 = (DFF / 64) * (D / 64), I_O = (D / 64) * (D / 64), I_BR = (512 / 64) * (D / 64);
    constexpr int NIT = I_IN + I_F1 + I_F2 + I_O + 4 * I_BR;
    const int n0 = (mask & 1) ? I_IN : 0, n1 = (mask & 2) ? I_F1 : 0, n2 = (mask & 4) ? I_F2 : 0, n3 = (mask & 8) ? I_O : 0, n4 = (mask & 16) ? 4 * I_BR : 0;
    const int total = n0 + n1 + n2 + n3 + n4;
    for (int it = gw; it < total; it += NGW) {
        int r = it;
        if (r < n0) { transpose_item(p.w_in + (size_t)l * D * INC, D, INC, (bf16_t*)(p.ws + OFF_WIN), scr, r, lane, D); continue; } r -= n0;
        if (r < n1) { transpose_item(p.w_ff1 + (size_t)l * D * DFF, D, DFF, (bf16_t*)(p.ws + OFF_WFF1), scr, r, lane, D); continue; } r -= n1;
        if (r < n2) { transpose_item(p.w_ff2 + (size_t)l * DFF * D, DFF, D, (bf16_t*)(p.ws + OFF_WFF2), scr, r, lane, DFF); continue; } r -= n2;
        if (r < n3) { transpose_item(p.w_out + (size_t)l * D * D, D, D, (bf16_t*)(p.ws + OFF_WOUT), scr, r, lane, D); continue; } r -= n3;
        const int nb = r / I_BR; r -= nb * I_BR;
        transpose_item(p.w_branch + ((size_t)l * 4 + nb) * 512 * D, 512, D, (bf16_t*)(p.ws + OFF_WBR) + (size_t)nb * 512, scr, r, lane, D);
    }
}
__device__ __forceinline__ void phase_A(const Params& p, LAS unsigned char* lds, int tid) {
    const int blk = blockIdx.x, G = gridDim.x;
    float* mod = (float*)(p.ws + OFF_MOD);
    for (int item = blk; item < 96; item += G) {
        LAS float* ssil = (LAS float*)lds;
        LAS float* red = (LAS float*)(lds + 40960);
        for (int idx = tid; idx < 5 * D; idx += NTHR) { const int r = idx >> 11, k = idx & 2047; const float cv = r < 4 ? p.c[r * D + k] : p.cctx[k]; ssil[idx] = cv / (1.f + __expf(-cv)); }
        __syncthreads();
        const int l = item / 48, n0 = (item % 48) * 256, cgi = tid & 63, ks = tid >> 6;
        float acc[5][4];
#pragma unroll
        for (int r = 0; r < 5; ++r)
#pragma unroll
            for (int j = 0; j < 4; ++j) acc[r][j] = 0.f;
        const float* wp = p.w_ada + ((size_t)(l * D + ks * 256)) * 12288 + n0 + cgi * 4;
#pragma unroll 4
        for (int k = 0; k < 256; ++k) { const f32x4 w = __builtin_nontemporal_load((const f32x4*)(wp + (size_t)k * 12288));
#pragma unroll
            for (int r = 0; r < 5; ++r) { const float s = ssil[r * D + ks * 256 + k];
#pragma unroll
                for (int j = 0; j < 4; ++j) acc[r][j] += s * w[j]; } }
#pragma unroll
        for (int r = 0; r < 5; ++r)
#pragma unroll
            for (int j = 0; j < 4; ++j) red[(ks * 64 + cgi) * 20 + r * 4 + j] = acc[r][j];
        __syncthreads();
        for (int o = tid; o < 1280; o += NTHR) { const int r = o >> 8, cc = o & 255; float s = p.b_ada[l * 12288 + n0 + cc];
#pragma unroll
            for (int k2 = 0; k2 < 8; ++k2) s += red[(k2 * 64 + (cc >> 2)) * 20 + r * 4 + (cc & 3)];
            mod[(size_t)(l * 5 + r) * 12288 + n0 + cc] = s; }
        __syncthreads();
    }
    float* rc = (float*)(p.ws + OFF_ROPEC); float* rs = (float*)(p.ws + OFF_ROPES);
    for (int idx = blk * NTHR + tid; idx < 4096 * 64; idx += G * NTHR) { const int t = idx >> 6, s = idx & 63; const int pos = s < 32 ? (t >> 6) : (t & 63);
        const float fr = __builtin_amdgcn_exp2f(-(float)(s & 31) * (13.287712379549449f / 32.f)); const float rev = (float)pos * fr * 0.15915494309189535f;
        rc[idx] = __builtin_amdgcn_cosf(rev); rs[idx] = __builtin_amdgcn_sinf(rev); }
    convert_weights(p, 0, lds, tid, 31, blk, G);
}

__device__ __forceinline__ void rowop(const Params& p, int nrows, const float* xin_lat, const float* xin_ctx, bool has_add, int l_add, int which_gate, int gi_add,
                                      bool has_xout, float* xout_lat, float* xout_ctx, bool has_h, int l_h, int gi_h, int which_sc, int which_sh, int nz_ctx, int tid, const bool xin_b16, const bool xout_b16) {
    const int wave = tid >> 6, lane = tid & 63;
    const float* mod = (const float*)(p.ws + OFF_MOD);
    const bf16_t* add = (const bf16_t*)(p.ws + OFF_F);
    const bf16_t* part = (const bf16_t*)(p.ws + OFF_PART);
    bf16_t* hout = (bf16_t*)(p.ws + OFF_A);
    const int NGW = gridDim.x * 8;
    auto load_row = [&](int row, f32x4 (&x)[8], f32x4 (&a)[8]) {
        if (row < NLAT && xin_b16) { const bf16_t* xb = (const bf16_t*)xin_lat + (size_t)row * D;
#pragma unroll
            for (int j = 0; j < 8; ++j) { const u32x2 r = __builtin_nontemporal_load((const u32x2*)(xb + (j * 64 + lane) * 4)); x[j][0] = blo(r.x); x[j][1] = bhi(r.x); x[j][2] = blo(r.y); x[j][3] = bhi(r.y); }
        } else { const float* xi = row < NLAT ? xin_lat + (size_t)row * D : xin_ctx + (size_t)(row - NLAT) * D;
#pragma unroll
            for (int j = 0; j < 8; ++j) x[j] = __builtin_nontemporal_load((const f32x4*)(xi + (j * 64 + lane) * 4)); }
        if (has_add) {
            if (row >= NLAT && nz_ctx > 0) {
#pragma unroll
                for (int j = 0; j < 8; ++j) a[j] = (f32x4){0.f, 0.f, 0.f, 0.f};
                for (int z = 0; z < nz_ctx; ++z) { const bf16_t* ap = part + ((size_t)z * NCTX + (row - NLAT)) * D;
#pragma unroll
                    for (int j = 0; j < 8; ++j) { const u32x2 r = *(const u32x2*)(ap + (j * 64 + lane) * 4); a[j][0] += blo(r.x); a[j][1] += bhi(r.x); a[j][2] += blo(r.y); a[j][3] += bhi(r.y); } }
            } else { const bf16_t* ap = add + (size_t)row * D;
#pragma unroll
                for (int j = 0; j < 8; ++j) { const u32x2 r = __builtin_nontemporal_load((const u32x2*)(ap + (j * 64 + lane) * 4)); a[j][0] = blo(r.x); a[j][1] = bhi(r.x); a[j][2] = blo(r.y); a[j][3] = bhi(r.y); } }
        }
    };
    auto proc_row = [&](int row, f32x4 (&x)[8], f32x4 (&a)[8]) {
        const int r = row < NLAT ? (row >> 12) : 4;
        if (has_add) {
            float ss = 0.f;
#pragma unroll
            for (int j = 0; j < 8; ++j) ss += a[j][0] * a[j][0] + a[j][1] * a[j][1] + a[j][2] * a[j][2] + a[j][3] * a[j][3];
            ss = wave_sum(ss); const float rs = rsqrtf(ss * (1.f / D) + EPS);
            const float* gn = p.norm_g + (size_t)(l_add * 4 + gi_add) * D; const float* gt = mod + (size_t)(l_add * 5 + r) * 12288 + which_gate * D;
#pragma unroll
            for (int j = 0; j < 8; ++j) { const int col = (j * 64 + lane) * 4; const f32x4 g4 = *(const f32x4*)(gn + col), t4 = *(const f32x4*)(gt + col); x[j] = x[j] + t4 * (a[j] * rs * g4); }
            if (has_xout) {
                if (row < NLAT && xout_b16) { bf16_t* xb = (bf16_t*)xout_lat + (size_t)row * D;
#pragma unroll
                    for (int j = 0; j < 8; ++j) { u32x2 o; o.x = pk2(x[j][0], x[j][1]); o.y = pk2(x[j][2], x[j][3]); __builtin_nontemporal_store(o, (u32x2*)(xb + (j * 64 + lane) * 4)); }
                } else { float* xo = row < NLAT ? xout_lat + (size_t)row * D : xout_ctx + (size_t)(row - NLAT) * D;
#pragma unroll
                    for (int j = 0; j < 8; ++j) __builtin_nontemporal_store(x[j], (f32x4*)(xo + (j * 64 + lane) * 4)); } }
        }
        if (has_h) {
            float ss = 0.f;
#pragma unroll
            for (int j = 0; j < 8; ++j) ss += x[j][0] * x[j][0] + x[j][1] * x[j][1] + x[j][2] * x[j][2] + x[j][3] * x[j][3];
            ss = wave_sum(ss); const float rs = rsqrtf(ss * (1.f / D) + EPS);
            const float* gn = p.norm_g + (size_t)(l_h * 4 + gi_h) * D; const float* sc = mod + (size_t)(l_h * 5 + r) * 12288 + which_sc * D; const float* sh = mod + (size_t)(l_h * 5 + r) * 12288 + which_sh * D;
#pragma unroll
            for (int j = 0; j < 8; ++j) { const int col = (j * 64 + lane) * 4; const f32x4 g4 = *(const f32x4*)(gn + col), s4 = *(const f32x4*)(sc + col), h4 = *(const f32x4*)(sh + col);
                const f32x4 v = (x[j] * rs * g4) * (s4 + 1.f) + h4; u32x2 o; o.x = pk2(v[0], v[1]); o.y = pk2(v[2], v[3]); *(u32x2*)(hout + (size_t)row * D + col) = o; }
        }
    };
    int r0 = blockIdx.x * 8 + wave;
    if (r0 < nrows) {
        f32x4 xA[8], aA[8], xB[8], aB[8];
        load_row(r0, xA, aA);
#pragma unroll 1
        for (;;) {
            const int r1 = r0 + NGW;
            if (r1 < nrows) load_row(r1, xB, aB);
            proc_row(r0, xA, aA);
            if (r1 >= nrows) break;
            r0 = r1 + NGW;
            if (r0 < nrows) load_row(r0, xA, aA);
            proc_row(r1, xB, aB);
            if (r0 >= nrows) break;
        }
    }
}

__device__ __forceinline__ void gen_dft(const Params& p, LAS unsigned char* lds, int tid, int vb, int nvb) {
    LAS bf16_t* lut = (LAS bf16_t*)lds;
    for (int m = tid; m < 4096; m += NTHR) lut[m] = f2bf(__builtin_amdgcn_cosf((float)m * (1.f / 4096.f)));
    __syncthreads();
    bf16_t* T = (bf16_t*)(p.ws + OFF_DFTP);
    for (int v = vb * NTHR + tid; v < 4096 * 512; v += nvb * NTHR) { const int k = v >> 9, n8 = (v & 511) * 8;
        unsigned w[4];
#pragma unroll
        for (int i = 0; i < 4; ++i) { unsigned ab[2];
#pragma unroll
            for (int e = 0; e < 2; ++e) { const int n = n8 + 2 * i + e; unsigned val;
                if (n < 2048) val = lut[(k * n) & 4095]; else if (n == 2048) val = lut[(k * 2048) & 4095]; else val = lut[(k * (n - 2048) + 1024) & 4095];
                ab[e] = val; }
            w[i] = ab[0] | (ab[1] << 16); }
        u32x4 o; o.x = w[0]; o.y = w[1]; o.z = w[2]; o.w = w[3]; *(u32x4*)(T + (size_t)k * 4096 + n8) = o; }
    bf16_t* Tc = (bf16_t*)(p.ws + OFF_DFTCP);
    for (int v = vb * NTHR + tid; v < 256 * 32; v += nvb * NTHR) { const int k = v >> 5, n8 = (v & 31) * 8;
        unsigned w[4];
#pragma unroll
        for (int i = 0; i < 4; ++i) { unsigned ab[2];
#pragma unroll
            for (int e = 0; e < 2; ++e) { const int n = n8 + 2 * i + e; unsigned val;
                if (n < 128) val = lut[(k * n * 16) & 4095]; else if (n == 128) val = lut[(k * 2048) & 4095]; else val = lut[(k * (n - 128) * 16 + 1024) & 4095];
                ab[e] = val; }
            w[i] = ab[0] | (ab[1] << 16); }
        u32x4 o; o.x = w[0]; o.y = w[1]; o.z = w[2]; o.w = w[3]; *(u32x4*)(Tc + (size_t)k * 256 + n8) = o; }
    __syncthreads();
}

__device__ __forceinline__ void ustate_item(const Params& p, int l, int item, LAS unsigned char* lds, int tid) {
    const int wave = tid >> 6, lane = tid & 63, fr = lane & 15, fq = lane >> 4;
    const bf16_t* P = (const bf16_t*)(p.ws + OFF_P);
    const float* ropec = (const float*)(p.ws + OFF_ROPEC); const float* ropes = (const float*)(p.ws + OFF_ROPES);
    bf16_t* Sg = (bf16_t*)(p.ws + OFF_S); bf16_t* Sc = (bf16_t*)(p.ws + OFF_SCTX);
    int h, c, row0; bool rope; bf16_t *Uf, *Ub;
    if (item < 512) { const int bh = item >> 5; c = item & 31; const int b = bh >> 2; h = bh & 3; row0 = b * SEQ + c * 128; rope = true;
        Uf = Sg + ((size_t)bh * 32 + c) * 16384; Ub = Sg + ((size_t)(16 + bh) * 32 + c) * 16384; }
    else { const int it = item - 512, bh = it >> 1; c = it & 1; const int b = bh >> 2; h = bh & 3; row0 = NLAT + b * CTXL + c * 128; rope = false;
        Uf = Sc + ((size_t)(bh * 2 + 0) * 2 + c) * 16384; Ub = Sc + ((size_t)(bh * 2 + 1) * 2 + c) * 16384; }
    const float lgf = log_sigmoid_(p.ret_decay[l * 8 + h]), lgb = log_sigmoid_(p.ret_decay[l * 8 + 4 + h]);
    const float kscale = 0.08838834764831845f;
    LAS bf16_t* kT = (LAS bf16_t*)lds; LAS bf16_t* vF = (LAS bf16_t*)(lds + 34816); LAS bf16_t* vB = (LAS bf16_t*)(lds + 69632);
#pragma unroll
    for (int w = 0; w < 2; ++w) { const int wk = tid + w * NTHR, j = wk & 127, dg = wk >> 7, d0 = dg * 8;
        const bf16_t* kp = P + (size_t)(row0 + j) * INC + C_K + h * 128 + d0;
        const u32x4 r1 = *(const u32x4*)kp, r2 = *(const u32x4*)(kp + 64);
        float k1[8], k2[8];
        k1[0] = blo(r1.x); k1[1] = bhi(r1.x); k1[2] = blo(r1.y); k1[3] = bhi(r1.y); k1[4] = blo(r1.z); k1[5] = bhi(r1.z); k1[6] = blo(r1.w); k1[7] = bhi(r1.w);
        k2[0] = blo(r2.x); k2[1] = bhi(r2.x); k2[2] = blo(r2.y); k2[3] = bhi(r2.y); k2[4] = blo(r2.z); k2[5] = bhi(r2.z); k2[6] = blo(r2.w); k2[7] = bhi(r2.w);
        if (rope) { const int t = c * 128 + j; const float* cp = ropec + t * 64 + d0; const float* sp = ropes + t * 64 + d0;
            const f32x4 c0 = *(const f32x4*)cp, c1 = *(const f32x4*)(cp + 4), s0 = *(const f32x4*)sp, s1 = *(const f32x4*)(sp + 4);
#pragma unroll
            for (int i = 0; i < 8; ++i) { const float cs = i < 4 ? c0[i & 3] : c1[i & 3], sn = i < 4 ? s0[i & 3] : s1[i & 3]; const float a = k1[i], bq = k2[i]; k1[i] = a * cs - bq * sn; k2[i] = a * sn + bq * cs; } }
#pragma unroll
        for (int i = 0; i < 8; ++i) { kT[(d0 + i) * 136 + j] = f2bf(k1[i] * kscale); kT[(d0 + 64 + i) * 136 + j] = f2bf(k2[i] * kscale); }
    }
#pragma unroll
    for (int w = 0; w < 4; ++w) { const int wk = tid + w * NTHR, j = wk & 127, v0 = (wk >> 7) * 8;
        const u32x4 rv = *(const u32x4*)(P + (size_t)(row0 + j) * INC + C_V + h * 128 + v0);
        const float wf = __expf(lgf * (float)(127 - j)), wb = __expf(lgb * (float)j);
        float vv[8]; vv[0] = blo(rv.x); vv[1] = bhi(rv.x); vv[2] = blo(rv.y); vv[3] = bhi(rv.y); vv[4] = blo(rv.z); vv[5] = bhi(rv.z); vv[6] = blo(rv.w); vv[7] = bhi(rv.w);
#pragma unroll
        for (int i = 0; i < 8; ++i) { vF[(v0 + i) * 136 + j] = f2bf(vv[i] * wf); vB[(v0 + i) * 136 + j] = f2bf(vv[i] * wb); } }
    __syncthreads();
#pragma unroll
    for (int dir = 0; dir < 2; ++dir) {
        LAS bf16_t* vX = dir == 0 ? vF : vB; bf16_t* U = dir == 0 ? Uf : Ub;
        f32x4 acc[8];
#pragma unroll
        for (int i = 0; i < 8; ++i) acc[i] = (f32x4){0.f, 0.f, 0.f, 0.f};
#pragma unroll
        for (int ks = 0; ks < 4; ++ks) { const bf16x8 a = *(const LAS bf16x8*)(kT + (wave * 16 + fr) * 136 + ks * 32 + fq * 8);
#pragma unroll
            for (int vt = 0; vt < 8; ++vt) { const bf16x8 bb = *(const LAS bf16x8*)(vX + (vt * 16 + fr) * 136 + ks * 32 + fq * 8); acc[vt] = MFMA16(a, bb, acc[vt]); } }
#pragma unroll
        for (int vt = 0; vt < 8; ++vt) { const int v = vt * 16 + fr, d0 = wave * 16 + fq * 4; u32x2 o; o.x = pk2(acc[vt][0], acc[vt][1]); o.y = pk2(acc[vt][2], acc[vt][3]); *(u32x2*)(U + v * 128 + d0) = o; }
    }
    __syncthreads();
}
__device__ __forceinline__ void scan_phase(const Params& p, int l, int tid) {
    bf16_t* Sg = (bf16_t*)(p.ws + OFF_S); const bf16_t* Sc = (const bf16_t*)(p.ws + OFF_SCTX);
    for (int gidx = blockIdx.x * NTHR + tid; gidx < 16 * 2 * 4096; gidx += gridDim.x * NTHR) {
        const int e4 = gidx & 4095, dir = (gidx >> 12) & 1, bh = gidx >> 13, h = bh & 3;
        const float dec = __expf(log_sigmoid_(p.ret_decay[l * 8 + dir * 4 + h]) * 128.f);
        bf16_t* base = Sg + ((size_t)(dir * 16 + bh) * 32) * 16384 + e4 * 4;
        const bf16_t* uc = Sc + ((size_t)(bh * 2 + dir) * 2) * 16384 + e4 * 4;
        const u32x2 u0 = *(const u32x2*)uc, u1 = *(const u32x2*)(uc + 16384);
        u32x2 uu[32];
#pragma unroll
        for (int c = 0; c < 32; ++c) uu[c] = *(const u32x2*)(base + (size_t)c * 16384);
        float S0, S1, S2, S3;
        if (dir == 0) { S0 = dec * blo(u0.x) + blo(u1.x); S1 = dec * bhi(u0.x) + bhi(u1.x); S2 = dec * blo(u0.y) + blo(u1.y); S3 = dec * bhi(u0.y) + bhi(u1.y);
#pragma unroll
            for (int c = 0; c < 32; ++c) { u32x2 o; o.x = pk2(S0, S1); o.y = pk2(S2, S3); *(u32x2*)(base + (size_t)c * 16384) = o;
                S0 = dec * S0 + blo(uu[c].x); S1 = dec * S1 + bhi(uu[c].x); S2 = dec * S2 + blo(uu[c].y); S3 = dec * S3 + bhi(uu[c].y); } }
        else { S0 = blo(u0.x) + dec * blo(u1.x); S1 = bhi(u0.x) + dec * bhi(u1.x); S2 = blo(u0.y) + dec * blo(u1.y); S3 = bhi(u0.y) + dec * bhi(u1.y);
#pragma unroll
            for (int c = 31; c >= 0; --c) { u32x2 o; o.x = pk2(S0, S1); o.y = pk2(S2, S3); *(u32x2*)(base + (size_t)c * 16384) = o;
                S0 = dec * S0 + blo(uu[c].x); S1 = dec * S1 + bhi(uu[c].x); S2 = dec * S2 + blo(uu[c].y); S3 = dec * S3 + bhi(uu[c].y); } }
    }
}

__device__ __forceinline__ void fnet1_build_ct(LAS unsigned char* lds, int tid) {
    LAS bf16_t* Ct = (LAS bf16_t*)lds;
    for (int e = tid; e < 256 * 128; e += NTHR) { const int jp = e >> 7, m = e & 127, j = jp & 127; const float a = (float)((j * m) & 127) * (1.f / 128.f);
        Ct[jp * 136 + m] = f2bf(jp < 128 ? __builtin_amdgcn_cosf(a) : __builtin_amdgcn_sinf(a)); }
    __syncthreads();
}
__device__ __forceinline__ void fnet1_item(const Params& p, int item, LAS unsigned char* lds, int tid) {
    const int wave = tid >> 6, lane = tid & 63, fr = lane & 15, fq = lane >> 4;
    LAS bf16_t* Ct = (LAS bf16_t*)lds; LAS bf16_t* Up = (LAS bf16_t*)(lds + 69632); LAS bf16_t* Um = (LAS bf16_t*)(lds + 104448);
    const bf16_t* P = (const bf16_t*)(p.ws + OFF_P);
    int b, g, seq0, L, ld, n0; bf16_t* PQ;
    if (item < 256) { b = item >> 6; g = (item >> 4) & 3; const int t = item & 15; seq0 = b * SEQ; L = SEQ; ld = 4096; n0 = t * 128; PQ = (bf16_t*)(p.ws + OFF_PQ); }
    else { const int it = item - 256; b = it >> 2; g = it & 3; seq0 = NLAT + b * CTXL; L = CTXL; ld = 256; n0 = 0; PQ = (bf16_t*)(p.ws + OFF_PQC); }
    const int H = L >> 1;
#pragma unroll
    for (int w = 0; w < 4; ++w) { const int v = tid + w * NTHR, r = v >> 4, c8 = (v & 15) * 8, n = n0 + r;
        const u32x4 a = *(const u32x4*)(P + (size_t)(seq0 + n) * INC + C_F + g * 128 + c8);
        u32x4 m; m.x = 0; m.y = 0; m.z = 0; m.w = 0;
        if (n > 0) m = *(const u32x4*)(P + (size_t)(seq0 + L - n) * INC + C_F + g * 128 + c8);
        u32x4 op, om;
        op.x = pk2(blo(a.x) + blo(m.x), bhi(a.x) + bhi(m.x)); op.y = pk2(blo(a.y) + blo(m.y), bhi(a.y) + bhi(m.y)); op.z = pk2(blo(a.z) + blo(m.z), bhi(a.z) + bhi(m.z)); op.w = pk2(blo(a.w) + blo(m.w), bhi(a.w) + bhi(m.w));
        om.x = pk2(blo(a.x) - blo(m.x), bhi(a.x) - bhi(m.x)); om.y = pk2(blo(a.y) - blo(m.y), bhi(a.y) - bhi(m.y)); om.z = pk2(blo(a.z) - blo(m.z), bhi(a.z) - bhi(m.z)); om.w = pk2(blo(a.w) - blo(m.w), bhi(a.w) - bhi(m.w));
        if (n == 0) { om.x = 0; om.y = 0; om.z = 0; om.w = 0; }
        *(LAS u32x4*)(Up + r * 136 + c8) = op; *(LAS u32x4*)(Um + r * 136 + c8) = om; }
    __syncthreads();
    f32x4 acc[16];
#pragma unroll
    for (int i = 0; i < 16; ++i) acc[i] = (f32x4){0.f, 0.f, 0.f, 0.f};
#pragma unroll
    for (int ks = 0; ks < 4; ++ks) { const bf16x8 ap = *(const LAS bf16x8*)(Up + (wave * 16 + fr) * 136 + ks * 32 + fq * 8), am = *(const LAS bf16x8*)(Um + (wave * 16 + fr) * 136 + ks * 32 + fq * 8);
#pragma unroll
        for (int ct = 0; ct < 16; ++ct) { const bf16x8 bb = *(const LAS bf16x8*)(Ct + (ct * 16 + fr) * 136 + ks * 32 + fq * 8); acc[ct] = MFMA16(ct < 8 ? ap : am, bb, acc[ct]); } }
#pragma unroll
    for (int ct = 0; ct < 16; ++ct) { const int jp = ct * 16 + fr, jrow = jp & 127, off = (jp >> 7) * H;
        u32x2 o; o.x = pk2(acc[ct][0], acc[ct][1]); o.y = pk2(acc[ct][2], acc[ct][3]);
        bf16_t* dst = PQ + (size_t)((b * 4 + g) * 128 + jrow) * ld + off + n0 + wave * 16 + fq * 4;
        if (ct >= 8 && n0 == 0 && wave == 0 && fq == 0) { dst[1] = (bf16_t)(o.x >> 16); dst[2] = (bf16_t)(o.y & 0xffffu); dst[3] = (bf16_t)(o.y >> 16); }
        else *(u32x2*)dst = o; }
    if (n0 == 0 && tid < 128) {
        const int j = tid; float s = 0.f;
        for (int m = 0; m < 128; ++m) s += bf2f(P[(size_t)(seq0 + H) * INC + C_F + g * 128 + m]) * bf2f(Ct[j * 136 + m]);
        PQ[(size_t)((b * 4 + g) * 128 + j) * ld + H] = f2bf(s); }
    __syncthreads();
}

__device__ __forceinline__ void conv_item(const Params& p, int l, int item, LAS unsigned char* lds, int tid) {
    const int wave = tid >> 6, lane = tid & 63;
    const bf16_t* P = (const bf16_t*)(p.ws + OFF_P);
    bf16_t* Y = (bf16_t*)(p.ws + OFF_A);
    LAS bf16_t* Z = (LAS bf16_t*)lds;
    LAS float* O = (LAS float*)(lds + 63488);
    const int row0 = item * 32;
    int seq0, Ls;
    if (row0 < NLAT) { seq0 = (row0 >> 12) << 12; Ls = SEQ; } else { seq0 = NLAT + (((row0 - NLAT) >> 8) << 8); Ls = CTXL; }
    const int tpos0 = row0 - seq0;
    const int sch0 = (tid & 63) * 8, st0 = (tid >> 6) * 4;
    u32x4 scc[6], scx[6], scb[4];
#pragma unroll
    for (int r = 0; r < 6; ++r) { const int t2 = tpos0 + st0 + r - 1; scc[r] = (u32x4){0u, 0u, 0u, 0u}; scx[r] = scc[r];
        if (t2 >= 0 && t2 < Ls) { const bf16_t* rp = P + (size_t)(seq0 + t2) * INC; scc[r] = *(const u32x4*)(rp + C_SC + sch0); scx[r] = *(const u32x4*)(rp + C_SX + sch0); } }
#pragma unroll
    for (int q = 0; q < 4; ++q) scb[q] = *(const u32x4*)(P + (size_t)(seq0 + tpos0 + st0 + q) * INC + C_SB + sch0);
    {
        u32x4 za[8], zb[8];
#pragma unroll
        for (int it = 0; it < 8; ++it) { const int v = tid + it * NTHR, r = v >> 6, c8 = (v & 63) * 8, tp = tpos0 - 15 + r;
            za[it] = (u32x4){0u, 0u, 0u, 0u}; zb[it] = za[it];
            if (v < 62 * 64 && tp >= 0 && tp < Ls) { const bf16_t* rp = P + (size_t)(seq0 + tp) * INC; za[it] = *(const u32x4*)(rp + C_CA + c8); zb[it] = *(const u32x4*)(rp + C_CB + c8); } }
#pragma unroll
        for (int it = 0; it < 8; ++it) { const int v = tid + it * NTHR, r = v >> 6, c8 = (v & 63) * 8; const u32x4 a = za[it], bb = zb[it];
            u32x4 o;
            o.x = pk2(blo(a.x) * sigmoidf_(blo(bb.x)), bhi(a.x) * sigmoidf_(bhi(bb.x))); o.y = pk2(blo(a.y) * sigmoidf_(blo(bb.y)), bhi(a.y) * sigmoidf_(bhi(bb.y)));
            o.z = pk2(blo(a.z) * sigmoidf_(blo(bb.z)), bhi(a.z) * sigmoidf_(bhi(bb.z))); o.w = pk2(blo(a.w) * sigmoidf_(blo(bb.w)), bhi(a.w) * sigmoidf_(bhi(bb.w)));
            if (v < 62 * 64) *(LAS u32x4*)(Z + r * 512 + c8) = o; }
    }
    __syncthreads();
    const int ch = tid;
    {
        float w0[31];
#pragma unroll
        for (int w = 0; w < 31; ++w) w0[w] = p.cf_conv[(size_t)(l * 31 + w) * 512 + ch];
#pragma unroll 1
        for (int tg = 0; tg < 8; ++tg) { float a0 = 0.f, a1 = 0.f, a2 = 0.f, a3 = 0.f;
#pragma unroll
            for (int r = 0; r < 34; ++r) { const float zz = bf2f(Z[(tg * 4 + r) * 512 + ch]);
                if (r <= 30) a0 += zz * w0[r <= 30 ? r : 0];
                if (r >= 1 && r <= 31) a1 += zz * w0[(r >= 1 && r <= 31) ? r - 1 : 0];
                if (r >= 2 && r <= 32) a2 += zz * w0[(r >= 2 && r <= 32) ? r - 2 : 0];
                if (r >= 3) a3 += zz * w0[r >= 3 ? r - 3 : 0]; }
            O[(tg * 4 + 0) * 512 + ch] = a0; O[(tg * 4 + 1) * 512 + ch] = a1; O[(tg * 4 + 2) * 512 + ch] = a2; O[(tg * 4 + 3) * 512 + ch] = a3; }
    }
    {
        f32x4 wlo[3], whi[3];
#pragma unroll
        for (int w = 0; w < 3; ++w) { const float* wp = p.sc_conv + (size_t)(l * 3 + w) * 512 + sch0; wlo[w] = *(const f32x4*)wp; whi[w] = *(const f32x4*)(wp + 4); }
        f32x4 plo[6], phi[6];
#pragma unroll
        for (int r = 0; r < 6; ++r) { plo[r][0] = blo(scc[r].x) * blo(scx[r].x); plo[r][1] = bhi(scc[r].x) * bhi(scx[r].x); plo[r][2] = blo(scc[r].y) * blo(scx[r].y); plo[r][3] = bhi(scc[r].y) * bhi(scx[r].y);
            phi[r][0] = blo(scc[r].z) * blo(scx[r].z); phi[r][1] = bhi(scc[r].z) * bhi(scx[r].z); phi[r][2] = blo(scc[r].w) * blo(scx[r].w); phi[r][3] = bhi(scc[r].w) * bhi(scx[r].w); }
#pragma unroll
        for (int q = 0; q < 4; ++q) { const f32x4 alo = wlo[0] * plo[q] + wlo[1] * plo[q + 1] + wlo[2] * plo[q + 2], ahi = whi[0] * phi[q] + whi[1] * phi[q + 1] + whi[2] * phi[q + 2];
            u32x4 o; o.x = pk2(blo(scb[q].x) * alo[0], bhi(scb[q].x) * alo[1]); o.y = pk2(blo(scb[q].y) * alo[2], bhi(scb[q].y) * alo[3]);
            o.z = pk2(blo(scb[q].z) * ahi[0], bhi(scb[q].z) * ahi[1]); o.w = pk2(blo(scb[q].w) * ahi[2], bhi(scb[q].w) * ahi[3]);
            *(u32x4*)(Y + (size_t)(seq0 + tpos0 + st0 + q) * D + 1024 + sch0) = o; }
    }
    __syncthreads();
    {
        const float* lg = p.cf_ln + (size_t)(l * 2 + 0) * 512 + lane * 8; const float* lb = p.cf_ln + (size_t)(l * 2 + 1) * 512 + lane * 8;
        const f32x4 g0 = *(const f32x4*)lg, g1 = *(const f32x4*)(lg + 4), b0 = *(const f32x4*)lb, b1 = *(const f32x4*)(lb + 4);
#pragma unroll 1
        for (int q = 0; q < 4; ++q) { const int t = wave * 4 + q;
            f32x4 v0 = *(const LAS f32x4*)(O + t * 512 + lane * 8), v1 = *(const LAS f32x4*)(O + t * 512 + lane * 8 + 4);
            float s = v0[0] + v0[1] + v0[2] + v0[3] + v1[0] + v1[1] + v1[2] + v1[3]; s = wave_sum(s); const float mu = s * (1.f / 512.f);
            v0 = v0 - mu; v1 = v1 - mu;
            float q2 = v0[0] * v0[0] + v0[1] * v0[1] + v0[2] * v0[2] + v0[3] * v0[3] + v1[0] * v1[0] + v1[1] * v1[1] + v1[2] * v1[2] + v1[3] * v1[3]; q2 = wave_sum(q2);
            const float rs = rsqrtf(q2 * (1.f / 512.f) + EPS);
            v0 = v0 * rs * g0 + b0; v1 = v1 * rs * g1 + b1;
#pragma unroll
            for (int e = 0; e < 4; ++e) { v0[e] = v0[e] * sigmoidf_(v0[e]); v1[e] = v1[e] * sigmoidf_(v1[e]); }
            u32x4 o; o.x = pk2(v0[0], v0[1]); o.y = pk2(v0[2], v0[3]); o.z = pk2(v1[0], v1[1]); o.w = pk2(v1[2], v1[3]);
            *(u32x4*)(Y + (size_t)(row0 + t) * D + 1536 + lane * 8) = o; }
    }
    __syncthreads();
}

__device__ __forceinline__ void ret_item(const Params& p, int l, int item, LAS unsigned char* lds, int tid) {
    asm volatile("" : "+v"(tid));
    const int wave = tid >> 6, lane = tid & 63, fr = lane & 15, fq = lane >> 4;
    const bf16_t* P = (const bf16_t*)(p.ws + OFF_P);
    bf16_t* Y = (bf16_t*)(p.ws + OFF_A);
    const float* ropec = (const float*)(p.ws + OFF_ROPEC); const float* ropes = (const float*)(p.ws + OFF_ROPES);
    const bf16_t* Sg = (const bf16_t*)(p.ws + OFF_S); const bf16_t* Sc = (const bf16_t*)(p.ws + OFF_SCTX);
    int h, c, row0; bool rope, hasF, hasB; const bf16_t *SF, *SB;
    if (item < 512) { const int bh = item >> 5; c = item & 31; const int b = bh >> 2; h = bh & 3; row0 = b * SEQ + c * 128; rope = true; hasF = true; hasB = true;
        SF = Sg + ((size_t)bh * 32 + c) * 16384; SB = Sg + ((size_t)(16 + bh) * 32 + c) * 16384; }
    else { const int it = item - 512, bh = it >> 1; c = it & 1; const int b = bh >> 2; h = bh & 3; row0 = NLAT + b * CTXL + c * 128; rope = false; hasF = (c == 1); hasB = (c == 0);
        SF = Sc + ((size_t)(bh * 2 + 0) * 2 + 0) * 16384; SB = Sc + ((size_t)(bh * 2 + 1) * 2 + 1) * 16384; }
    const float LOG2E = 1.4426950408889634f;
    const float lf2 = log_sigmoid_(p.ret_decay[l * 8 + h]) * LOG2E, lb2 = log_sigmoid_(p.ret_decay[l * 8 + 4 + h]) * LOG2E;
    const float kscale = 0.08838834764831845f;
    LAS bf16_t* R0 = (LAS bf16_t*)lds; LAS bf16_t* R1 = (LAS bf16_t*)(lds + 34816); LAS bf16_t* R2 = (LAS bf16_t*)(lds + 69632); LAS bf16_t* R3 = (LAS bf16_t*)(lds + 104448);
    u32x4 rq1[2], rq2[2], rk1[2], rk2[2], rvv[4], rgt[4], rsf[4], rsb[4]; f32x4 c0[2], c1[2], s0[2], s1[2];
#pragma unroll
    for (int w = 0; w < 2; ++w) { const int wk = tid + w * NTHR, j = wk >> 3, d0 = (wk & 7) * 8;
        const bf16_t* qp = P + (size_t)(row0 + j) * INC + C_Q + h * 128 + d0; const bf16_t* kp = P + (size_t)(row0 + j) * INC + C_K + h * 128 + d0;
        rq1[w] = *(const u32x4*)qp; rq2[w] = *(const u32x4*)(qp + 64); rk1[w] = *(const u32x4*)kp; rk2[w] = *(const u32x4*)(kp + 64);
        c0[w] = (f32x4){1.f, 1.f, 1.f, 1.f}; c1[w] = c0[w]; s0[w] = (f32x4){0.f, 0.f, 0.f, 0.f}; s1[w] = s0[w];
        if (rope) { const int t = c * 128 + j; const float* cp = ropec + t * 64 + d0; const float* sp = ropes + t * 64 + d0; c0[w] = *(const f32x4*)cp; c1[w] = *(const f32x4*)(cp + 4); s0[w] = *(const f32x4*)sp; s1[w] = *(const f32x4*)(sp + 4); } }
#pragma unroll
    for (int w = 0; w < 4; ++w) { const int wk = tid + w * NTHR;
        { const int r = wk >> 4, c8 = (wk & 15) * 8;
          rsf[w] = (u32x4){0u, 0u, 0u, 0u}; rsb[w] = rsf[w];
          if (hasF) rsf[w] = *(const u32x4*)(SF + (size_t)r * 128 + c8);
          if (hasB) rsb[w] = *(const u32x4*)(SB + (size_t)r * 128 + c8); } }
#pragma unroll
    for (int w = 0; w < 2; ++w) { const int wk = tid + w * NTHR, j = wk >> 3, d0 = (wk & 7) * 8;
#pragma unroll
        for (int which = 0; which < 2; ++which) {
            const u32x4 r1 = which == 0 ? rq1[w] : rk1[w], r2 = which == 0 ? rq2[w] : rk2[w];
            const float scl = which == 0 ? 1.f : kscale;
            float k1[8], k2[8];
            k1[0] = blo(r1.x); k1[1] = bhi(r1.x); k1[2] = blo(r1.y); k1[3] = bhi(r1.y); k1[4] = blo(r1.z); k1[5] = bhi(r1.z); k1[6] = blo(r1.w); k1[7] = bhi(r1.w);
            k2[0] = blo(r2.x); k2[1] = bhi(r2.x); k2[2] = blo(r2.y); k2[3] = bhi(r2.y); k2[4] = blo(r2.z); k2[5] = bhi(r2.z); k2[6] = blo(r2.w); k2[7] = bhi(r2.w);
#pragma unroll
            for (int i = 0; i < 8; ++i) { const float cs = i < 4 ? c0[w][i & 3] : c1[w][i & 3], sn = i < 4 ? s0[w][i & 3] : s1[w][i & 3]; const float a = k1[i], bq = k2[i]; k1[i] = (a * cs - bq * sn) * scl; k2[i] = (a * sn + bq * cs) * scl; }
            u32x4 o1, o2; o1.x = pk2(k1[0], k1[1]); o1.y = pk2(k1[2], k1[3]); o1.z = pk2(k1[4], k1[5]); o1.w = pk2(k1[6], k1[7]);
            o2.x = pk2(k2[0], k2[1]); o2.y = pk2(k2[2], k2[3]); o2.z = pk2(k2[4], k2[5]); o2.w = pk2(k2[6], k2[7]);
            LAS bf16_t* dstb = which == 0 ? R0 : R1;
            *(LAS u32x4*)(dstb + j * 136 + d0) = o1; *(LAS u32x4*)(dstb + j * 136 + 64 + d0) = o2;
        }
    }
#pragma unroll
    for (int w = 0; w < 4; ++w) { const int wk = tid + w * NTHR, r = wk >> 4, c8 = (wk & 15) * 8; *(LAS u32x4*)(R2 + r * 136 + c8) = rsf[w]; *(LAS u32x4*)(R3 + r * 136 + c8) = rsb[w]; }
    __syncthreads();
#pragma unroll
    for (int w = 0; w < 4; ++w) { const int wk = tid + w * NTHR;
        { const int j = wk & 127, v0 = (wk >> 7) * 8; rvv[w] = *(const u32x4*)(P + (size_t)(row0 + j) * INC + C_V + h * 128 + v0); }
 }
    unsigned spk[8][2];
    {
    f32x4 sa[8];
#pragma unroll
    for (int i = 0; i < 8; ++i) sa[i] = (f32x4){0.f, 0.f, 0.f, 0.f};
#pragma unroll
    for (int kk = 0; kk < 4; ++kk) { const bf16x8 a = *(const LAS bf16x8*)(R0 + (wave * 16 + fr) * 136 + kk * 32 + fq * 8);
#pragma unroll
        for (int jt = 0; jt < 8; ++jt) { const bf16x8 bb = *(const LAS bf16x8*)(R1 + (jt * 16 + fr) * 136 + kk * 32 + fq * 8); sa[jt] = MFMA16(a, bb, sa[jt]); } }
#pragma unroll
    for (int jt = 0; jt < 8; ++jt) { float wv[4];
#pragma unroll
        for (int jj = 0; jj < 4; ++jj) { const int i = wave * 16 + fq * 4 + jj, j = jt * 16 + fr, df = i - j;
            const float wgt = df >= 0 ? __builtin_amdgcn_exp2f(lf2 * (float)df) : __builtin_amdgcn_exp2f(lb2 * (float)(-df)); wv[jj] = sa[jt][jj] * wgt; }
        spk[jt][0] = pk2(wv[0], wv[1]); spk[jt][1] = pk2(wv[2], wv[3]); }
    }
#pragma unroll
    for (int w = 0; w < 4; ++w) { const int wk = tid + w * NTHR, r = wk >> 4, c8 = (wk & 15) * 8; rgt[w] = *(const u32x4*)(P + (size_t)(row0 + r) * INC + C_G + h * 128 + c8); }
    f32x4 y[8];
#pragma unroll
    for (int i = 0; i < 8; ++i) y[i] = (f32x4){0.f, 0.f, 0.f, 0.f};
    if (hasF) {
        f32x4 t[8];
#pragma unroll
        for (int i = 0; i < 8; ++i) t[i] = (f32x4){0.f, 0.f, 0.f, 0.f};
#pragma unroll
        for (int kk = 0; kk < 4; ++kk) { const bf16x8 a = *(const LAS bf16x8*)(R0 + (wave * 16 + fr) * 136 + kk * 32 + fq * 8);
#pragma unroll
            for (int vt = 0; vt < 8; ++vt) { const bf16x8 bb = *(const LAS bf16x8*)(R2 + (vt * 16 + fr) * 136 + kk * 32 + fq * 8); t[vt] = MFMA16(a, bb, t[vt]); } }
#pragma unroll
        for (int jj = 0; jj < 4; ++jj) { const int i = wave * 16 + fq * 4 + jj; const float sc = __builtin_amdgcn_exp2f(lf2 * (float)(i + 1));
#pragma unroll
            for (int vt = 0; vt < 8; ++vt) y[vt][jj] += t[vt][jj] * sc; }
    }
    if (hasB) {
        f32x4 t[8];
#pragma unroll
        for (int i = 0; i < 8; ++i) t[i] = (f32x4){0.f, 0.f, 0.f, 0.f};
#pragma unroll
        for (int kk = 0; kk < 4; ++kk) { const bf16x8 a = *(const LAS bf16x8*)(R0 + (wave * 16 + fr) * 136 + kk * 32 + fq * 8);
#pragma unroll
            for (int vt = 0; vt < 8; ++vt) { const bf16x8 bb = *(const LAS bf16x8*)(R3 + (vt * 16 + fr) * 136 + kk * 32 + fq * 8); t[vt] = MFMA16(a, bb, t[vt]); } }
#pragma unroll
        for (int jj = 0; jj < 4; ++jj) { const int i = wave * 16 + fq * 4 + jj; const float sc = __builtin_amdgcn_exp2f(lb2 * (float)(128 - i));
#pragma unroll
            for (int vt = 0; vt < 8; ++vt) y[vt][jj] += t[vt][jj] * sc; }
    }
    __syncthreads();
#pragma unroll
    for (int jt = 0; jt < 8; ++jt) { const int i0 = wave * 16 + fq * 4, j = jt * 16 + fr;
        R2[(i0 + 0) * 136 + j] = (bf16_t)(spk[jt][0] & 0xffffu); R2[(i0 + 1) * 136 + j] = (bf16_t)(spk[jt][0] >> 16);
        R2[(i0 + 2) * 136 + j] = (bf16_t)(spk[jt][1] & 0xffffu); R2[(i0 + 3) * 136 + j] = (bf16_t)(spk[jt][1] >> 16); }
#pragma unroll
    for (int w = 0; w < 4; ++w) { const int wk = tid + w * NTHR;
        { const int j = wk & 127, v0 = (wk >> 7) * 8; const u32x4 rv = rvv[w];
          R3[(v0 + 0) * 136 + j] = (bf16_t)(rv.x & 0xffffu); R3[(v0 + 1) * 136 + j] = (bf16_t)(rv.x >> 16);
          R3[(v0 + 2) * 136 + j] = (bf16_t)(rv.y & 0xffffu); R3[(v0 + 3) * 136 + j] = (bf16_t)(rv.y >> 16);
          R3[(v0 + 4) * 136 + j] = (bf16_t)(rv.z & 0xffffu); R3[(v0 + 5) * 136 + j] = (bf16_t)(rv.z >> 16);
          R3[(v0 + 6) * 136 + j] = (bf16_t)(rv.w & 0xffffu); R3[(v0 + 7) * 136 + j] = (bf16_t)(rv.w >> 16); }
        { const int r = wk >> 4, c8 = (wk & 15) * 8; *(LAS u32x4*)(R1 + r * 136 + c8) = rgt[w]; } }
    __syncthreads();
#pragma unroll
    for (int kk = 0; kk < 4; ++kk) { const bf16x8 a = *(const LAS bf16x8*)(R2 + (wave * 16 + fr) * 136 + kk * 32 + fq * 8);
#pragma unroll
        for (int vt = 0; vt < 8; ++vt) { const bf16x8 bb = *(const LAS bf16x8*)(R3 + (vt * 16 + fr) * 136 + kk * 32 + fq * 8); y[vt] = MFMA16(a, bb, y[vt]); } }
#pragma unroll
    for (int jj = 0; jj < 4; ++jj) { const int i = wave * 16 + fq * 4 + jj;
        float s = 0.f;
#pragma unroll
        for (int vt = 0; vt < 8; ++vt) s += y[vt][jj];
        s += __shfl_xor(s, 1); s += __shfl_xor(s, 2); s += __shfl_xor(s, 4); s += __shfl_xor(s, 8);
        const float mu = s * (1.f / 128.f); float q2 = 0.f;
#pragma unroll
        for (int vt = 0; vt < 8; ++vt) { const float dv = y[vt][jj] - mu; q2 += dv * dv; }
        q2 += __shfl_xor(q2, 1); q2 += __shfl_xor(q2, 2); q2 += __shfl_xor(q2, 4); q2 += __shfl_xor(q2, 8);
        const float rs = rsqrtf(q2 * (1.f / 128.f) + EPS);
#pragma unroll
        for (int vt = 0; vt < 8; ++vt) { const int v = vt * 16 + fr; const float gt = bf2f(R1[i * 136 + v]);
            R0[i * 136 + v] = f2bf((y[vt][jj] - mu) * rs * gt * sigmoidf_(gt)); } }
    __syncthreads();
#pragma unroll
    for (int w = 0; w < 4; ++w) { const int wk = tid + w * NTHR, r = wk >> 4, c8 = (wk & 15) * 8;
        *(u32x4*)(Y + (size_t)(row0 + r) * D + h * 128 + c8) = *(const LAS u32x4*)(R0 + r * 136 + c8); }
    __syncthreads();
}

#define XB_TMO      128
#define XB_XCNT(j)  (256  + 64 * (j))
#define XB_XSUB(j)  (1280 + 64 * (j))
#define XB_XGEN(j)  (2304 + 64 * (j))
#define XB_TOP      3328
#define XB_TOPGEN   3392
#define XB_SPIN_CAP (1u << 18)
__device__ __forceinline__ unsigned xb_ld(unsigned* p)              { return __hip_atomic_load(p, __ATOMIC_RELAXED, __HIP_MEMORY_SCOPE_AGENT); }
__device__ __forceinline__ unsigned xb_add(unsigned* p, unsigned v) { return __hip_atomic_fetch_add(p, v, __ATOMIC_RELAXED, __HIP_MEMORY_SCOPE_AGENT); }
__device__ __forceinline__ unsigned xb_xcc_id() { return (unsigned)__builtin_amdgcn_s_getreg((3 << 11) | 20) & 0xFu; }
#define XB_SPIN(cond, bar) do { unsigned _sp = 0; while (cond) { __builtin_amdgcn_s_sleep(1); \
    if ((++_sp & 255u) == 0u) { if (xb_ld(&(bar)[XB_TMO])) break; if (_sp > XB_SPIN_CAP) { atomicAdd(&(bar)[XB_TMO], 1u); break; } } } } while (0)
struct XcdBarrier { unsigned* bar; unsigned x; volatile LAS unsigned* st; };
__device__ __forceinline__ XcdBarrier xcd_barrier_post(unsigned* bar, volatile LAS unsigned* st) {
    XcdBarrier b; b.bar = bar; b.x = xb_xcc_id(); b.st = st;
    if (threadIdx.x == 0) (void)xb_add(&bar[XB_XCNT(b.x)], 1u);
    return b;
}
__device__ __forceinline__ void xcd_barrier_complete(unsigned* bar, unsigned x, unsigned& nloc, unsigned& nx) {
    const unsigned G = gridDim.x * gridDim.y * gridDim.z;
    unsigned sum, cnt, mine, sp = 0u;
    for (;;) {
        sum = 0u; cnt = 0u; mine = 0u;
#pragma unroll
        for (unsigned j = 0; j < 16; ++j) { const unsigned c = xb_ld(&bar[XB_XCNT(j)]); sum += c; cnt += (c > 0u) ? 1u : 0u; mine = (j == x) ? c : mine; }
        if (sum == G) break;
        __builtin_amdgcn_s_sleep(1);
        if ((++sp & 255u) == 0u) { if (xb_ld(&bar[XB_TMO])) break; if (sp > XB_SPIN_CAP) { atomicAdd(&bar[XB_TMO], 1u); break; } }
    }
    nloc = mine > 0u ? mine : 1u; nx = cnt > 0u ? cnt : 1u;
}
__device__ __forceinline__ void xcd_barrier(const XcdBarrier& b) {
    asm volatile("s_waitcnt vmcnt(0)" ::: "memory");
    __syncthreads();
    if (threadIdx.x == 0) {
        unsigned* bar = b.bar;
        __builtin_amdgcn_s_waitcnt(0);
        unsigned nloc = b.st[0], nx = b.st[1];
        if (nloc == 0u) { xcd_barrier_complete(bar, b.x, nloc, nx); b.st[0] = nloc; b.st[1] = nx; }
        const unsigned old = xb_add(&bar[XB_XSUB(b.x)], 1u);
        const unsigned gen = old / nloc;
        if (old + 1u == (gen + 1u) * nloc) {
            __builtin_amdgcn_fence(__ATOMIC_RELEASE, "agent");
            asm volatile("s_waitcnt vmcnt(0)" ::: "memory");
            const unsigned og = xb_add(&bar[XB_TOP], 1u);
            const unsigned tg = og / nx;
            if (og + 1u == (tg + 1u) * nx) xb_add(&bar[XB_TOPGEN], 1u);
            else XB_SPIN(xb_ld(&bar[XB_TOPGEN]) == tg, bar);
            __builtin_amdgcn_fence(__ATOMIC_ACQUIRE, "agent");
            xb_add(&bar[XB_XGEN(b.x)], 1u);
            asm volatile("s_waitcnt vmcnt(0)" ::: "memory");
        } else {
            XB_SPIN(xb_ld(&bar[XB_XGEN(b.x)]) == gen, bar);
            __builtin_amdgcn_fence(__ATOMIC_ACQUIRE, "agent");
            asm volatile("s_waitcnt vmcnt(0)" ::: "memory");
        }
    }
    __syncthreads();
}

__device__ __forceinline__ void run_phase(const Params& p, int ph, LAS unsigned char* lds) {
    int tid = threadIdx.x; asm volatile("" : "+v"(tid));
    int blk = blockIdx.x, G = gridDim.x; asm volatile("" : "+s"(blk), "+s"(G));
    float* xc = (float*)(p.ws + OFF_XC);
    if (ph >= 22) return;
    if (ph == 0) { phase_A(p, lds, tid); return; }
    float* xbs = (float*)(p.ws + OFF_XB);
    if (ph == 21) { rowop(p, NLAT, xbs, xc, true, 1, 5, 3, true, p.out, xc, false, 0, 0, 0, 0, 0, tid, true, false); return; }
    const int l = (ph - 1) / 10; int s = (ph - 1) % 10;
    if (s == 3) { scan_phase(p, l, tid); return; }
    if (s > 3) --s;
    const int M_l = (l == 0) ? NROW : NLAT;
    bf16_t* Pb = (bf16_t*)(p.ws + OFF_P); bf16_t* Ab = (bf16_t*)(p.ws + OFF_A); float* Fb = (float*)(p.ws + OFF_F);
    if (s == 0) {
        if (l == 0) rowop(p, NROW, p.x, p.ctx, false, 0, 0, 0, false, nullptr, nullptr, true, 0, 0, 1, 0, 0, tid, false, false);
        else { rowop(p, NROW, xbs, xc, true, l - 1, 5, 3, true, xbs, xc, true, l, 0, 1, 0, 8, tid, true, true); convert_weights(p, l, lds, tid, G > 128 ? 6 : 31, blk, G); }
    } else if (s == 1 || s == 7) {
#pragma unroll 1
        for (int q = 0; q < 2; ++q) {
            pg8::Gemm g; pg8::Sched S; pg8::EpiBf16 E; E.zstride = 0; g.lda = D; g.ldb = D; g.K = D; g.zA = 0; g.zB = 0;
            if (s == 1) {
                g.Bt = (const bf16_t*)(p.ws + OFF_WIN); E.ldc = INC; E.act = 2;
                if (q == 0) { g.A = Ab; S.init(M_l, INC, 1, G, blk); E.O = Pb; }
                else { if (l == 0) break; g.A = Ab + (size_t)NLAT * D; S.init(NCTX, 1024, 1, G, blk >= G - 16 ? blk - (G - 16) : (1 << 20)); E.O = Pb + (size_t)NLAT * INC; }
            } else { if (q == 1) break; g.A = Ab; g.Bt = (const bf16_t*)(p.ws + OFF_WFF1); S.init(M_l, DFF, 1, G, blk); E.O = Pb; E.ldc = DFF; E.act = 1; }
            pg8::gemm_phase(lds, g, S, E, tid);
        }
        if (s == 1 && l == 0) gen_dft(p, lds, tid, blk, G);
        if (s == 7 && l == 0 && G > 128 && blk >= 128) convert_weights(p, 1, lds, tid, 25, blk - 128, G - 128);
    } else if (s == 2) {
        for (int it = blk; it < 544; it += G) ustate_item(p, l, it, lds, tid);
        const int nf = (l == 0) ? 272 : 256, b1 = (blk + G / 4) % G, b2 = (blk + G / 2) % G;
        if (b1 < nf) { fnet1_build_ct(lds, tid); for (int it = b1; it < nf; it += G) fnet1_item(p, it, lds, tid); }
        for (int it = b2; it < M_l / 32; it += G) conv_item(p, l, it, lds, tid);
    } else if (s == 3) {
#pragma unroll 1
        for (int q = 0; q < 2; ++q) {
            pg8::Gemm g; pg8::Sched S; pg8::EpiFnet E; g.zA = 0; g.zB = 0; E.Y = Ab;
            if (q == 0) { g.A = (const bf16_t*)(p.ws + OFF_DFTP); g.Bt = (const bf16_t*)(p.ws + OFF_PQ); g.lda = 4096; g.ldb = 4096; g.K = 4096; S.init(SEQ, 2048, 1, G, blk);
                E.rowbase = 0; E.Lseq = SEQ; E.scale = 0.0013810679320049757f; }
            else { if (l != 0) break; g.A = (const bf16_t*)(p.ws + OFF_DFTCP); g.Bt = (const bf16_t*)(p.ws + OFF_PQC); g.lda = 256; g.ldb = 256; g.K = 256;
                S.init(CTXL, 2048, 1, G, (G > 136 && blk >= 128) ? blk - 128 : blk);
                E.rowbase = NLAT; E.Lseq = CTXL; E.scale = 0.005524271728019903f; }
            pg8::gemm_phase(lds, g, S, E, tid);
        }
        int ob = blk, NOB = G;
        if (G > 128) { if (blk < 128) return; ob = blk - 128; NOB = G - 128; }
        const int nr = (l == 0) ? 544 : 512;
        for (int it = ob; it < nr; it += NOB) ret_item(p, l, it, lds, tid);
    } else if (s == 4) {
        pg8::Gemm g; pg8::Sched S; pg8::EpiGate E;
        g.A = Ab; g.Bt = (const bf16_t*)(p.ws + OFF_WBR); g.lda = D; g.ldb = D; g.K = 512; g.zA = 512; g.zB = 512; S.init(M_l, D, 4, G, blk);
        E.P = Pb;
        pg8::gemm_phase(lds, g, S, E, tid);
    } else if (s == 5 || s == 8) {
#pragma unroll 1
        for (int q = 0; q < 2; ++q) {
            pg8::Gemm g; pg8::Sched S; pg8::EpiBf16 E; E.ldc = D; E.act = 0;
            const int Kf = (s == 5) ? D : DFF, zK = (s == 5) ? 4 : 8;
            g.lda = (s == 5) ? INC : DFF; g.ldb = Kf; g.Bt = (const bf16_t*)(p.ws + (s == 5 ? OFF_WOUT : OFF_WFF2));
            if (q == 0) { g.A = Pb; g.K = Kf; g.zA = 0; g.zB = 0; S.init(NLAT, D, 1, G, blk); E.O = (bf16_t*)Fb; E.zstride = 0; }
            else { if (l != 0) break; g.A = Pb + (size_t)NLAT * g.lda; g.K = Kf / zK; g.zA = (size_t)(Kf / zK); g.zB = (size_t)(Kf / zK); S.init(NCTX, D * zK, 1, G, blk); S.zsplit = 8;
                E.O = (bf16_t*)(p.ws + OFF_PART); E.zstride = (size_t)NCTX * D; }
            pg8::gemm_phase(lds, g, S, E, tid);
        }
    } else if (s == 6) {
        if (l == 0) rowop(p, NROW, p.x, p.ctx, true, l, 2, 1, true, xbs, xc, true, l, 2, 4, 3, 4, tid, false, true);
        else rowop(p, NLAT, xbs, xc, true, l, 2, 1, true, xbs, xc, true, l, 2, 4, 3, 0, tid, true, true);
    }
}

__global__ __launch_bounds__(512, 2) void mega(Params p, int ph_lo, int ph_hi) {
    extern __shared__ __attribute__((aligned(16))) unsigned char shm[];
    LAS unsigned char* lds = (LAS unsigned char*)shm;
    cg::grid_group grid = cg::this_grid();
    volatile LAS unsigned* st = (volatile LAS unsigned*)(lds + 147392);
    if (threadIdx.x == 0) { st[0] = 0u; st[1] = 0u; }
    __syncthreads();
    (void)xcd_barrier_post((unsigned*)(p.ws + OFF_BAR), st);
    if (ph_lo < 0) grid.sync();
#if REP_T1 >= 0
    const int n_extra = (REP_T2 >= 0) ? 2 : 1;
#else
    const int n_extra = 0;
#endif
    for (int i = ph_lo; i < ph_hi + n_extra; ++i) {
        int ph = i;
#if REP_T1 >= 0
        ph = i - (i > REP_T1 ? 1 : 0) - ((REP_T2 >= 0 && i > REP_T2 + 1) ? 1 : 0);
#endif
        const __attribute__((address_space(4))) Params* pp = (const __attribute__((address_space(4))) Params*)__builtin_amdgcn_kernarg_segment_ptr();
        asm volatile("" : "+s"(pp));
        run_phase(*(const Params*)pp, ph, lds);
        if (i + 1 < ph_hi + n_extra) { XcdBarrier xb; xb.bar = (unsigned*)(((const Params*)pp)->ws + OFF_BAR); xb.x = xb_xcc_id(); xb.st = (volatile LAS unsigned*)(lds + 147392); xcd_barrier(xb); }
    }
}

extern "C" void kernel_launch(void* const* d_in, const int* in_sizes, int n_in, void* d_out, int out_size, void* d_ws, size_t ws_size, hipStream_t stream) {
    static int grid = 0;
    if (grid == 0) {
        if (n_in != 16 || ws_size < WS_END) { fprintf(stderr, "kernel_launch: need 16 inputs and %zu bytes of workspace; got %d, %zu\n", (size_t)WS_END, n_in, ws_size); grid = -1; return; }
        int dev = 0, cus = 0, per_cu = 0;
        if (hipGetDevice(&dev) != hipSuccess || hipDeviceGetAttribute(&cus, hipDeviceAttributeMultiprocessorCount, dev) != hipSuccess) { grid = -1; return; }
        if (hipFuncSetAttribute((const void*)mega, hipFuncAttributeMaxDynamicSharedMemorySize, LDS_BYTES) != hipSuccess) { fprintf(stderr, "kernel_launch: hipFuncSetAttribute failed\n"); grid = -1; return; }
        if (hipOccupancyMaxActiveBlocksPerMultiprocessor(&per_cu, (const void*)mega, NTHR, LDS_BYTES) != hipSuccess || per_cu < 1) { fprintf(stderr, "kernel_launch: occupancy query gave %d\n", per_cu); per_cu = 1; }
        (void)hipGetLastError();
        grid = cus * 1;
    }
    if (grid < 0) return;
    Params p{};
    p.x = (const float*)d_in[0]; p.c = (const float*)d_in[1]; p.ctx = (const float*)d_in[2]; p.cctx = (const float*)d_in[3];
    p.w_ada = (const float*)d_in[4]; p.b_ada = (const float*)d_in[5]; p.norm_g = (const float*)d_in[6]; p.w_in = (const float*)d_in[7];
    p.ret_decay = (const float*)d_in[8]; p.sc_conv = (const float*)d_in[9]; p.cf_conv = (const float*)d_in[10]; p.cf_ln = (const float*)d_in[11];
    p.w_branch = (const float*)d_in[12]; p.w_out = (const float*)d_in[13]; p.w_ff1 = (const float*)d_in[14]; p.w_ff2 = (const float*)d_in[15];
    p.out = (float*)d_out; p.ws = (unsigned char*)d_ws;
    if (hipMemsetAsync((char*)d_ws + OFF_BAR, 0, BAR_BYTES, stream) != hipSuccess) { fprintf(stderr, "kernel_launch: memset of the barrier words failed\n"); return; }
    int lo = 0, hi = 22 + NULL_PHASES;
    void* args[] = {&p, &lo, &hi};
    hipError_t e = hipLaunchCooperativeKernel((const void*)mega, dim3(grid), dim3(NTHR), args, LDS_BYTES, stream);
    if (e != hipSuccess) fprintf(stderr, "cooperative launch failed: %s (grid %d)\n", hipGetErrorString(e), grid);
}
```
